# Optimizing an MI355X kernel written in HIP

```python
import math
import jax
import jax.numpy as jnp
from jax import lax
import numpy as np

D_MODEL = 1024
BATCH = 1
SEQ = 16384
DEPTH = 1
DEC_BATCH = 128
DEC_SEQ = 1
PAST_LEN = 16384
PAGE_SIZE = 128

HEAD_DIM = 64
ATTN_HEADS = 8
ATTN_KV_HEADS = 2
WINDOW = 128
N_BUCKETS = 32
MAX_DISTANCE = 128
GLA_HEADS = 4
GLA_DK = 64
GLA_DV = 128
GLA_RANK = 16
GLA_TAU = 16.0
GLA_CHUNK = 64
ATTN_WIDTH = ATTN_HEADS * HEAD_DIM
GLA_WIDTH = GLA_HEADS * GLA_DV
MIX_WIDTH = ATTN_WIDTH + GLA_WIDTH
D_FF = -(-8 * D_MODEL // (3 * 256)) * 256
SPLIT_SIZES = (ATTN_WIDTH, ATTN_KV_HEADS * HEAD_DIM, ATTN_KV_HEADS * HEAD_DIM,
               GLA_HEADS * GLA_DK, GLA_HEADS * GLA_DK, GLA_WIDTH, GLA_WIDTH, GLA_RANK)
IN_WIDTH = sum(SPLIT_SIZES)
EPS = 1e-6

kernel_name = "hymba_swa_sink_gla_decode_step"


def rmsnorm(x, g):
    xf = x.astype(jnp.float32)
    r = lax.rsqrt(jnp.mean(xf * xf, axis=-1, keepdims=True) + EPS)
    return (xf * r * g.astype(jnp.float32)).astype(x.dtype)


def t5_bucket(dist):
    n = jnp.maximum(dist, 0)
    max_exact = N_BUCKETS // 2
    nf = jnp.maximum(n, 1).astype(jnp.float32)
    large = max_exact + (jnp.log(nf / max_exact) / math.log(MAX_DISTANCE / max_exact)
                         * (N_BUCKETS - max_exact)).astype(jnp.int32)
    large = jnp.minimum(large, N_BUCKETS - 1)
    return jnp.where(n < max_exact, n, large)


def project(h, w_in, q_norm_g, k_norm_g, w_gla_gate2, b_gla_gate):
    N, T, _ = h.shape
    idx = [int(s) for s in np.cumsum(SPLIT_SIZES)[:-1]]
    u_qa, u_ka, u_va, u_qg, u_kg, u_vg, u_rg, u_lr = jnp.split(h @ w_in, idx, axis=-1)
    q_a = rmsnorm(u_qa.reshape(N, T, ATTN_HEADS, HEAD_DIM), q_norm_g)
    k_a = rmsnorm(u_ka.reshape(N, T, ATTN_KV_HEADS, HEAD_DIM), k_norm_g)
    v_a = u_va.reshape(N, T, ATTN_KV_HEADS, HEAD_DIM)
    q_g = u_qg.reshape(N, T, GLA_HEADS, GLA_DK) * (GLA_DK ** -0.5)
    k_g = u_kg.reshape(N, T, GLA_HEADS, GLA_DK)
    v_g = u_vg.reshape(N, T, GLA_HEADS, GLA_DV)
    log_a = jax.nn.log_sigmoid((u_lr @ w_gla_gate2 + b_gla_gate).astype(jnp.float32)) / GLA_TAU
    log_a = log_a.reshape(N, T, GLA_HEADS, GLA_DK)
    return q_a, k_a, v_a, q_g, k_g, v_g, u_rg, log_a


def sink_attention(q, k, v, dist, valid, rel_bias, sinks):
    N, Tq, H, hd = q.shape
    Tk, kvh = k.shape[1], k.shape[2]
    G = H // kvh
    qg = q.reshape(N, Tq, kvh, G, hd).astype(jnp.float32)
    s = jnp.einsum('nqkgd,nskd->nkgqs', qg, k.astype(jnp.float32)) * (hd ** -0.5)
    bias = rel_bias[t5_bucket(dist)].astype(jnp.float32)
    bias = jnp.transpose(bias, (2, 0, 1)).reshape(kvh, G, Tq, Tk)
    s = jnp.where(valid[:, None, None], s + bias, -jnp.inf)
    sk = sinks.astype(jnp.float32).reshape(kvh, G, 1, 1)
    m = jnp.maximum(jnp.max(s, axis=-1, keepdims=True), sk)
    p = jnp.exp(s - m)
    denom = jnp.sum(p, axis=-1, keepdims=True) + jnp.exp(sk - m)
    o = jnp.einsum('nkgqs,nskd->nqkgd', p / denom, v.astype(jnp.float32))
    return o.reshape(N, Tq, H * hd)


def prompt_window_attention(q, k, v, rel_bias, sinks):
    B, T, H, hd = q.shape
    kvh = k.shape[2]
    W = WINDOW
    nb = T // W
    qb = q.reshape(B * nb, W, H, hd)

    def pair(t):
        tb = t.reshape(B, nb, W, kvh, hd)
        prev = jnp.concatenate([jnp.zeros_like(tb[:, :1]), tb[:, :-1]], axis=1)
        return jnp.concatenate([prev, tb], axis=2).reshape(B * nb, 2 * W, kvh, hd)

    i = jnp.arange(W)[:, None]
    j = jnp.arange(2 * W)[None, :]
    dist = W + i - j
    band = (dist >= 0) & (dist < WINDOW)
    has_prev = (jnp.arange(nb) > 0)[:, None, None] | (j >= W)[None]
    valid = jnp.tile(band[None] & has_prev, (B, 1, 1))
    o = sink_attention(qb, pair(k), pair(v), dist, valid, rel_bias, sinks)
    return o.reshape(B, T, H * hd)


def sample_window_attention(q, k_new, v_new, k_buf, v_buf, rel_bias, sinks):
    Ts = q.shape[1]
    wb = k_buf.shape[1]
    k_all = jnp.concatenate([k_buf, k_new], axis=1)
    v_all = jnp.concatenate([v_buf, v_new], axis=1)
    dist = wb + jnp.arange(Ts)[:, None] - jnp.arange(wb + Ts)[None, :]
    valid = ((dist >= 0) & (dist < WINDOW))[None]
    o = sink_attention(q, k_all, v_all, dist, valid, rel_bias, sinks)
    return o, k_all[:, -wb:], v_all[:, -wb:]


def gla_chunked(q, k, v, log_a, s0):
    N, T, H, _ = q.shape
    C = min(GLA_CHUNK, T)
    pad = (-T) % C
    nc = (T + pad) // C

    def blocks(t):
        t = jnp.pad(t.astype(jnp.float32), ((0, 0), (0, pad), (0, 0), (0, 0)))
        return t.reshape(N, nc, C, H, t.shape[-1]).transpose(1, 0, 3, 2, 4)

    causal = jnp.arange(C)[:, None] >= jnp.arange(C)[None, :]

    def step(S, inp):
        qc, kc, vc, ac = inp
        b = jnp.cumsum(ac, axis=2)
        o_inter = jnp.einsum('nhtd,nhdv->nhtv', qc * jnp.exp(b), S)
        diff = b[:, :, :, None, :] - b[:, :, None, :, :]
        decay = jnp.exp(jnp.where(causal[:, :, None], diff, -jnp.inf))
        scores = jnp.einsum('nhtd,nhsd,nhtsd->nhts', qc, kc, decay)
        o = o_inter + jnp.einsum('nhts,nhsv->nhtv', scores, vc)
        b_last = b[:, :, -1:, :]
        S = (jnp.exp(b_last[:, :, 0, :, None]) * S
             + jnp.einsum('nhsd,nhsv->nhdv', kc * jnp.exp(b_last - b), vc))
        return S, o

    S, o = lax.scan(step, s0, (blocks(q), blocks(k), blocks(v), blocks(log_a)))
    o = o.transpose(1, 0, 3, 2, 4).reshape(N, nc * C, H, GLA_DV)[:, :T]
    return o, S


def finish(x, o_attn, o_gla, r_gla, gla_norm_g, w_o, ffn_norm_g, w_gate, w_up, w_down):
    N, T, _ = x.shape
    g = rmsnorm(o_gla.astype(x.dtype), gla_norm_g).reshape(N, T, GLA_WIDTH) * jax.nn.silu(r_gla)
    h = x + jnp.concatenate([o_attn.astype(x.dtype), g], axis=-1) @ w_o
    z = rmsnorm(h, ffn_norm_g)
    return h + (jax.nn.silu(z @ w_gate) * (z @ w_up)) @ w_down


def setup_inputs(seed: int = 0) -> dict:
    key = jax.random.key(seed)
    ks = jax.random.split(key, 20)
    wb = min(WINDOW, PAST_LEN)

    def nrm(k, shape, scale):
        return scale * jax.random.normal(k, shape, jnp.float32)

    return {
        "x_prompt": nrm(ks[0], (BATCH, SEQ, D_MODEL), 1.0),
        "x_sample": nrm(ks[1], (DEC_BATCH, DEC_SEQ, D_MODEL), 1.0),
        "cache_k": nrm(ks[2], (DEPTH, DEC_BATCH, wb, ATTN_KV_HEADS, HEAD_DIM), 1.0),
        "cache_v": nrm(ks[3], (DEPTH, DEC_BATCH, wb, ATTN_KV_HEADS, HEAD_DIM), 1.0),
        "state_gla": nrm(ks[4], (DEPTH, DEC_BATCH, GLA_HEADS, GLA_DK, GLA_DV), 0.3),
        "attn_norm_g": 1.0 + nrm(ks[5], (DEPTH, D_MODEL), 0.1),
        "w_in": nrm(ks[6], (DEPTH, D_MODEL, IN_WIDTH), D_MODEL ** -0.5),
        "q_norm_g": 1.0 + nrm(ks[7], (DEPTH, HEAD_DIM), 0.1),
        "k_norm_g": 1.0 + nrm(ks[8], (DEPTH, HEAD_DIM), 0.1),
        "attn_sinks": nrm(ks[9], (DEPTH, ATTN_HEADS), 0.5),
        "rel_bias": nrm(ks[10], (N_BUCKETS, ATTN_HEADS), 0.5),
        "w_gla_gate2": nrm(ks[11], (DEPTH, GLA_RANK, GLA_HEADS * GLA_DK), GLA_RANK ** -0.5),
        "b_gla_gate": nrm(ks[12], (DEPTH, GLA_HEADS * GLA_DK), 0.1),
        "gla_norm_g": 1.0 + nrm(ks[13], (DEPTH, GLA_DV), 0.1),
        "w_o": nrm(ks[14], (DEPTH, MIX_WIDTH, D_MODEL), MIX_WIDTH ** -0.5),
        "ffn_norm_g": 1.0 + nrm(ks[15], (DEPTH, D_MODEL), 0.1),
        "w_gate": nrm(ks[16], (DEPTH, D_MODEL, D_FF), D_MODEL ** -0.5),
        "w_up": nrm(ks[17], (DEPTH, D_MODEL, D_FF), D_MODEL ** -0.5),
        "w_down": nrm(ks[18], (DEPTH, D_FF, D_MODEL), D_FF ** -0.5),
    }


def reference(x_prompt, x_sample, cache_k, cache_v, state_gla, attn_norm_g, w_in, q_norm_g,
              k_norm_g, attn_sinks, rel_bias, w_gla_gate2, b_gla_gate, gla_norm_g, w_o,
              ffn_norm_g, w_gate, w_up, w_down):
    xp, xs = x_prompt, x_sample
    wb = cache_k.shape[2]
    kp_l, vp_l, sp_l, ks_l, vs_l, ss_l = [], [], [], [], [], []
    for l in range(DEPTH):
        proj_w = (w_in[l], q_norm_g[l], k_norm_g[l], w_gla_gate2[l], b_gla_gate[l])
        ffn_w = (gla_norm_g[l], w_o[l], ffn_norm_g[l], w_gate[l], w_up[l], w_down[l])
        q_a, k_a, v_a, q_g, k_g, v_g, r_g, log_a = project(rmsnorm(xp, attn_norm_g[l]), *proj_w)
        o_a = prompt_window_attention(q_a, k_a, v_a, rel_bias, attn_sinks[l])
        s0 = jnp.zeros((xp.shape[0], GLA_HEADS, GLA_DK, GLA_DV), jnp.float32)
        o_g, s_p = gla_chunked(q_g, k_g, v_g, log_a, s0)
        xp = finish(xp, o_a, o_g, r_g, *ffn_w)
        kp_l.append(k_a[:, -wb:])
        vp_l.append(v_a[:, -wb:])
        sp_l.append(s_p.astype(state_gla.dtype))
        q_a, k_a, v_a, q_g, k_g, v_g, r_g, log_a = project(rmsnorm(xs, attn_norm_g[l]), *proj_w)
        o_a, k_buf, v_buf = sample_window_attention(q_a, k_a, v_a, cache_k[l], cache_v[l],
                                                    rel_bias, attn_sinks[l])
        o_g, s_s = gla_chunked(q_g, k_g, v_g, log_a, state_gla[l].astype(jnp.float32))
        xs = finish(xs, o_a, o_g, r_g, *ffn_w)
        ks_l.append(k_buf)
        vs_l.append(v_buf)
        ss_l.append(s_s.astype(state_gla.dtype))
    k_win_prompt = jnp.stack(kp_l)
    v_win_prompt = jnp.stack(vp_l)
    gla_state_prompt = jnp.stack(sp_l)
    k_win_sample = jnp.stack(ks_l)
    v_win_sample = jnp.stack(vs_l)
    gla_state_sample = jnp.stack(ss_l)
    return (xp, xs, k_win_prompt, v_win_prompt, gla_state_prompt,
            k_win_sample, v_win_sample, gla_state_sample)
```

```cpp
#include <hip/hip_runtime.h>
#include <cstdio>
#include <cstdint>
#include <cmath>
namespace pg8 {
#define PG8_LAS __attribute__((address_space(3)))
typedef unsigned short bf16_t;
typedef short bf16x8 __attribute__((ext_vector_type(8)));
typedef float f32x4 __attribute__((ext_vector_type(4)));
typedef unsigned u32x4 __attribute__((ext_vector_type(4)));
constexpr int BM = 256, BK = 64, HALF = 128, HTB = HALF * BK * 2  , STAGE_BYTES = 8 * HTB, NXCD = 8, WGM = 4;

__host__ __device__ __forceinline__ int lds_byte(int r, int c) { const int st = (r >> 4) * 2 + (c >> 5), rr = r & 15, cc = c & 31, ob = rr * 64 + cc * 2; return st * 1024 + (ob ^ (((ob >> 9) & 1) << 5)); }
__host__ __device__ __forceinline__ void stage_rc(int b, int& R, int& C) { const int st = b / 1024, sb = b % 1024, swz = sb ^ (((sb >> 9) & 1) << 5); R = (st >> 1) * 16 + swz / 64; C = (st & 1) * 32 + (swz % 64) / 2; }
__host__ __device__ __forceinline__ int perm32(int rho) { const int n = rho >> 4, i = rho & 15; return 8 * (i >> 2) + 4 * n + (i & 3); }

struct Unit { int pm, pn; };
struct Gemm { const bf16_t* A; const bf16_t* Bt; int M, N, K; };

struct StaticOrder {
    int nM, nN, nwg, G, c;
    __host__ __device__ void init(int M, int N, int G_, int c_) { nM = M / BM; nN = N / BM; nwg = nM * nN; G = G_; c = c_; }
    __host__ __device__ bool next(int i, Unit& u) const {
        const long L = (long)i * G + c; if (L >= nwg) return false;
        int wgid = (int)L; { const int q = nwg / NXCD, r = nwg % NXCD, xcd = wgid % NXCD, off = wgid / NXCD; wgid = (xcd < r ? xcd * (q + 1) : r * (q + 1) + (xcd - r) * q) + off; }
        const int nig = WGM * nN, gid = wgid / nig, fm = gid * WGM, gsz = (nM - fm) < WGM ? (nM - fm) : WGM;
        u.pm = fm + ((wgid % nig) % gsz); u.pn = (wgid % nig) / gsz; return true;
    }
    __device__ __forceinline__ void a_ready(const Unit&) const {}
    __device__ __forceinline__ void done(const Unit&) const {}
};

__device__ __forceinline__ unsigned cvt_pk_bf16(float lo, float hi) { unsigned r; asm volatile("v_cvt_pk_bf16_f32 %0, %1, %2" : "=v"(r) : "v"(lo), "v"(hi)); return r; }
typedef float f32x2 __attribute__((ext_vector_type(2)));
constexpr int TP = 16384, NSMP = 128, MV = TP + NSMP, MP = 16640, DM = 1024;
constexpr int N1 = 2560, NFF = 2816, NGU = 2 * NFF;
constexpr float LOG2E = 1.4426950408889634f, EPS = 1e-6f;
constexpr size_t O_Y = 0, O_KWP = 16908288, O_VWP = 16924672, O_SP = 16941056, O_KWS = 16973824, O_VWS = 19070976, O_SS = 21168128;

__device__ __forceinline__ float silu_f(float x) { return x * __builtin_amdgcn_rcpf(1.f + __builtin_amdgcn_exp2f(-1.4426950408889634f * x)); }
__device__ __forceinline__ u32x4 pack8(const f32x4 a, const f32x4 b) { u32x4 w; w.x = cvt_pk_bf16(a[0], a[1]); w.y = cvt_pk_bf16(a[2], a[3]); w.z = cvt_pk_bf16(b[0], b[1]); w.w = cvt_pk_bf16(b[2], b[3]); return w; }
__device__ __forceinline__ void st16_wt(void* p, u32x4 v) { asm volatile("global_store_dwordx4 %0, %1, off sc1\n\ts_nop 1" :: "v"(p), "v"(v) : "memory"); }
typedef unsigned u32x2w __attribute__((ext_vector_type(2)));
__device__ __forceinline__ void st8_wt(void* p, u32x2w v) { asm volatile("global_store_dwordx2 %0, %1, off sc1\n\ts_nop 1" :: "v"(p), "v"(v) : "memory"); }
__device__ __forceinline__ void st16f_wt(void* p, f32x4 v) { asm volatile("global_store_dwordx4 %0, %1, off sc1\n\ts_nop 1" :: "v"(p), "v"(v) : "memory"); }
__device__ __forceinline__ float dot4(const f32x4 a) { return (a[0] * a[0] + a[1] * a[1]) + (a[2] * a[2] + a[3] * a[3]); }

struct EpiProj {
    static constexpr bool PERM = true, AFTER_DRAIN = false;
    const float* rstd; const float* qg; const float* kg;
    bf16_t *QKV, *GQ, *GK, *GV, *GR; bf16_t* LR; float* out; const float* bgate;
    struct Pre { float rs[8]; };
    __device__ __forceinline__ void prefetch(Pre& p, const Unit& u, int wr, int fr) const {
#pragma unroll
        for (int i = 0; i < 8; ++i) { p.rs[i] = rstd[u.pm * BM + wr * 64 + fr + (i >> 2) * HALF + (i & 3) * 16]; }
    }
    __device__ __forceinline__ void operator()(const f32x4 (&acc)[2][2][4][2], const Unit& u, int wr, int wc, int fr, int fq, const Pre& pre) const {
        const int pn = u.pn;
        const int rowb = u.pm * BM + wr * 64 + fr;
        if (pn < 3) {
            const int hh = 4 * pn + wc;
            f32x4 gw[2][2];
#pragma unroll
            for (int bj = 0; bj < 2; ++bj)
#pragma unroll
                for (int n = 0; n < 2; ++n) { const int d = 32 * bj + 8 * fq + 4 * n; gw[bj][n] = hh < 8 ? *(const f32x4*)(qg + d) : (hh < 10 ? *(const f32x4*)(kg + d) : (f32x4){1.f, 1.f, 1.f, 1.f}); }
            const float post = hh < 8 ? 0.125f * LOG2E : 1.f;
#pragma unroll
            for (int ai = 0; ai < 2; ++ai)
#pragma unroll
                for (int m = 0; m < 4; ++m) {
                    const int row = rowb + ai * HALF + m * 16;
                    const float rs = pre.rs[ai * 4 + m];
                    f32x4 v[2][2]; float ss = 0.f;
#pragma unroll
                    for (int bj = 0; bj < 2; ++bj)
#pragma unroll
                        for (int n = 0; n < 2; ++n) { v[bj][n] = acc[ai][bj][m][n] * rs; ss += dot4(v[bj][n]); }
                    if (hh < 10) {
                        ss += __shfl_xor(ss, 16); ss += __shfl_xor(ss, 32);
                        const float rh = __builtin_amdgcn_rsqf(ss * (1.f / 64.f) + EPS) * post;
#pragma unroll
                        for (int bj = 0; bj < 2; ++bj)
#pragma unroll
                            for (int n = 0; n < 2; ++n) v[bj][n] = v[bj][n] * rh * gw[bj][n];
                    }
                    bf16_t* dst = QKV + (size_t)row * 768 + hh * 64 + 8 * fq;
#pragma unroll
                    for (int bj = 0; bj < 2; ++bj) *(u32x4*)(dst + 32 * bj) = pack8(v[bj][0], v[bj][1]);
                    if (hh >= 8) {
                        float* o = nullptr;
                        if (row >= TP - 128 && row < TP) o = out + (hh < 10 ? O_KWP : O_VWP) + (size_t)(row - (TP - 128)) * 128 + (hh & 1) * 64;
                        else if (row >= TP && row < MV) o = out + (hh < 10 ? O_KWS : O_VWS) + ((size_t)(row - TP) * 128 + 127) * 128 + (hh & 1) * 64;
                        if (o) {
#pragma unroll
                            for (int bj = 0; bj < 2; ++bj)
#pragma unroll
                                for (int n = 0; n < 2; ++n) *(f32x4*)(o + 32 * bj + 8 * fq + 4 * n) = v[bj][n];
                        }
                    }
                }
        } else if (pn < 9) {
            bf16_t* base; int ld, cofs, mode;
            if (pn == 3) { base = GQ; ld = 256; cofs = 0; mode = 1; } else if (pn == 4) { base = GK; ld = 256; cofs = 0; mode = 0; }
            else if (pn < 7) { base = GV; ld = 512; cofs = (pn - 5) * 256; mode = 0; } else { base = GR; ld = 512; cofs = (pn - 7) * 256; mode = 2; }
#pragma unroll
            for (int ai = 0; ai < 2; ++ai)
#pragma unroll
                for (int m = 0; m < 4; ++m) {
                    const int row = rowb + ai * HALF + m * 16;
                    const float rs = pre.rs[ai * 4 + m];
                    bf16_t* dst = base + (size_t)row * ld + cofs + wc * 32 + 8 * fq;
#pragma unroll
                    for (int bj = 0; bj < 2; ++bj) {
                        f32x4 a = acc[ai][bj][m][0] * rs, b = acc[ai][bj][m][1] * rs;
                        if (mode == 1) { a = a * 0.125f; b = b * 0.125f; }
                        else if (mode == 2) {
#pragma unroll
                            for (int e = 0; e < 4; ++e) { a[e] = silu_f(a[e]); b[e] = silu_f(b[e]); }
                        }
                        *(u32x4*)(dst + bj * HALF) = pack8(a, b);
                    }
                }
        } else {
            f32x4 bbv[2][2];
#pragma unroll
            for (int bj = 0; bj < 2; ++bj)
#pragma unroll
                for (int n = 0; n < 2; ++n) bbv[bj][n] = *(const f32x4*)(bgate + bj * HALF + wc * 32 + 8 * fq + 4 * n);
#pragma unroll
            for (int ai = 0; ai < 2; ++ai)
#pragma unroll
                for (int m = 0; m < 4; ++m) {
                    const int row = rowb + ai * HALF + m * 16;
                    const float rs = pre.rs[ai * 4 + m];
#pragma unroll
                    for (int bj = 0; bj < 2; ++bj)
                    { f32x4 la2[2];
#pragma unroll
                        for (int n = 0; n < 2; ++n) { const f32x4 bb = bbv[bj][n]; const f32x4 z = acc[ai][bj][m][n] * rs + bb;
#pragma unroll
                            for (int e = 0; e < 4; ++e) la2[n][e] = (fminf(z[e], 0.f) - __logf(1.f + __expf(-fabsf(z[e])))) * 0.0625f; }
                        *(u32x4*)(LR + (size_t)row * 256 + bj * HALF + wc * 32 + 8 * fq) = pack8(la2[0], la2[1]); }
                }
        }
    }
};

struct EpiWo {
    static constexpr bool PERM = true, AFTER_DRAIN = false;
    const bf16_t* XB; bf16_t* HB; float* SS2;
    struct Pre {};
    __device__ __forceinline__ void prefetch(Pre&, const Unit&, int, int) const {}
    __device__ __forceinline__ void operator()(const f32x4 (&acc)[2][2][4][2], const Unit& u, int wr, int wc, int fr, int fq, const Pre& pre) const {
        const int rowb = u.pm * BM + wr * 64 + fr, col0 = u.pn * BM + wc * 32 + 8 * fq;
#pragma unroll
        for (int ai = 0; ai < 2; ++ai)
#pragma unroll
            for (int m = 0; m < 4; ++m) {
                const int row = rowb + ai * HALF + m * 16;
                if (row < MV) {
                    float ss = 0.f;
#pragma unroll
                    for (int bj = 0; bj < 2; ++bj) {
                        const size_t gi = (size_t)row * DM + col0 + bj * HALF;
                        const u32x4 xb = *(const u32x4*)(XB + gi);
                        const f32x4 x0 = {__uint_as_float(xb.x << 16), __uint_as_float(xb.x & 0xffff0000u), __uint_as_float(xb.y << 16), __uint_as_float(xb.y & 0xffff0000u)};
                        const f32x4 x1 = {__uint_as_float(xb.z << 16), __uint_as_float(xb.z & 0xffff0000u), __uint_as_float(xb.w << 16), __uint_as_float(xb.w & 0xffff0000u)};
                        const f32x4 h0 = x0 + acc[ai][bj][m][0], h1 = x1 + acc[ai][bj][m][1];
                        *(u32x4*)(HB + gi) = pack8(h0, h1);
                        ss += dot4(h0) + dot4(h1);
                    }
                    ss += __shfl_xor(ss, 16); ss += __shfl_xor(ss, 32);
                    if (fq == 0) __hip_atomic_fetch_add(SS2 + row, ss, __ATOMIC_RELAXED, __HIP_MEMORY_SCOPE_AGENT);
                }
            }
    }
};


struct SampleFirstOrder {
    StaticOrder base; int ns, G, c; unsigned* flag;
    __device__ void init(int Mprompt, int N, int G_, int c_, unsigned* flag_) { ns = N / BM; G = G_; c = c_; flag = flag_; base.init(Mprompt, N, G_, 0); }
    __device__ bool next(int i, Unit& u) const {
        const long L = (long)i * G + c;
        if (L < ns) { u.pm = Mprompt_panels(); u.pn = (int)L; return true; }
        StaticOrder b2 = base; b2.c = 0; b2.G = 1;
        return b2.next((int)(L - ns), u);
    }
    __device__ int Mprompt_panels() const { return base.nM; }
    __device__ __forceinline__ void a_ready(const Unit&) const {}
    __device__ __forceinline__ void done(const Unit& u) const {
        if (u.pm == base.nM) { asm volatile("s_waitcnt vmcnt(0)" ::: "memory"); if ((threadIdx.x & 63) == 0) __hip_atomic_fetch_add(flag, 1u, __ATOMIC_RELAXED, __HIP_MEMORY_SCOPE_AGENT); }
    }
};
struct EpiGU {
    static constexpr bool PERM = true, AFTER_DRAIN = false;
    const float* SS2; bf16_t* HID;
    struct Pre { float ssq[8]; };
    __device__ __forceinline__ void prefetch(Pre& p, const Unit& u, int wr, int fr) const {
#pragma unroll
        for (int i = 0; i < 8; ++i) { const int row = u.pm * BM + wr * 64 + fr + (i >> 2) * HALF + (i & 3) * 16; p.ssq[i] = SS2[row]; }
    }
    __device__ __forceinline__ void operator()(const f32x4 (&acc)[2][2][4][2], const Unit& u, int wr, int wc, int fr, int fq, const Pre& pre) const {
        const int rowb = u.pm * BM + wr * 64 + fr;
#pragma unroll
        for (int ai = 0; ai < 2; ++ai)
#pragma unroll
            for (int m = 0; m < 4; ++m) {
                const int row = rowb + ai * HALF + m * 16;
                const float rs = row < MV ? __builtin_amdgcn_rsqf(pre.ssq[ai * 4 + m] * (1.f / 1024.f) + EPS) : 0.f;
                f32x4 hv[2];
#pragma unroll
                for (int n = 0; n < 2; ++n) {
                    const f32x4 g = acc[ai][0][m][n] * rs, up = acc[ai][1][m][n] * rs;
#pragma unroll
                    for (int e = 0; e < 4; ++e) hv[n][e] = silu_f(g[e]) * up[e];
                }
                if (u.pm * BM >= TP) st16_wt(HID + (size_t)row * NFF + u.pn * HALF + wc * 32 + 8 * fq, pack8(hv[0], hv[1]));
                else *(u32x4*)(HID + (size_t)row * NFF + u.pn * HALF + wc * 32 + 8 * fq) = pack8(hv[0], hv[1]);
            }
    }
};

struct EpiDown {
    static constexpr bool PERM = true, AFTER_DRAIN = false;
    const bf16_t* HB; float* dsty;
    struct Pre {};
    __device__ __forceinline__ void prefetch(Pre&, const Unit&, int, int) const {}
    __device__ __forceinline__ void operator()(const f32x4 (&acc)[2][2][4][2], const Unit& u, int wr, int wc, int fr, int fq, const Pre& pre) const {
        const int rowb = u.pm * BM + wr * 64 + fr, col0 = u.pn * BM + wc * 32 + 8 * fq;
#pragma unroll
        for (int ai = 0; ai < 2; ++ai)
#pragma unroll
            for (int m = 0; m < 4; ++m) {
                const int row = rowb + ai * HALF + m * 16;
                if (row < MV) {
#pragma unroll
                    for (int bj = 0; bj < 2; ++bj) {
                        const size_t gi = (size_t)row * DM + col0 + bj * HALF;
                        const u32x4 hb = *(const u32x4*)(HB + gi);
                        const f32x4 h0 = {__uint_as_float(hb.x << 16), __uint_as_float(hb.x & 0xffff0000u), __uint_as_float(hb.y << 16), __uint_as_float(hb.y & 0xffff0000u)};
                        const f32x4 h1 = {__uint_as_float(hb.z << 16), __uint_as_float(hb.z & 0xffff0000u), __uint_as_float(hb.w << 16), __uint_as_float(hb.w & 0xffff0000u)};
                        __builtin_nontemporal_store(h0 + acc[ai][bj][m][0], (f32x4*)(dsty + gi));
                        __builtin_nontemporal_store(h1 + acc[ai][bj][m][1], (f32x4*)(dsty + gi + 4));
                    }
                }
            }
    }
};

template <class Epi, class Sched, bool ALIGN_EPI = false, bool SP2 = false>
__device__ __forceinline__ void gemm_phase(PG8_LAS unsigned char* lds, const Gemm g, const Sched& S, const Epi& E) {
    const int tid = threadIdx.x, wid = __builtin_amdgcn_readfirstlane(tid >> 6), lane = tid & 63, wr = wid >> 2, wc = wid & 3, fr = lane & 15, fq = lane >> 4;
    const int K = g.K, nt = K / BK;
    unsigned voffA[2], voffB[2];
#pragma unroll
    for (int i = 0; i < 2; ++i) { int R, C; stage_rc(tid * 16 + i * 8192, R, C); const int Rb = Epi::PERM ? ((R & ~31) + perm32(R & 31)) : R;
        voffA[i] = (unsigned)(R * K + C) * 2u; voffB[i] = (unsigned)(Rb * K + C) * 2u; }
    const size_t kstep = (size_t)(BK * 2);
    const size_t hstep = (size_t)HALF * K * 2;
    const size_t tstep = 2 * hstep;
    const unsigned ldsw = (unsigned)wid * 1024u;
    const int aoff = lds_byte(wr * 64 + fr, fq * 8), boff = lds_byte(wc * 32 + fr, fq * 8);
#define PG8_SA(b, h) (((b) * 2 + (h)) * HTB)
#define PG8_SB(b, h) ((4 + (b) * 2 + (h)) * HTB)
#define PG8_STAGE(bufoff, gbase, voff) do { _Pragma("unroll") for (int _i = 0; _i < 2; ++_i) \
        __builtin_amdgcn_global_load_lds((const unsigned*)((const char*)(gbase) + (voff)[_i]), (PG8_LAS unsigned*)(lds + (bufoff) + ldsw + _i * 8192), 16, 0, 0); } while (0)
#define PG8_LDA(dst, b, h) do { _Pragma("unroll") for (int m = 0; m < 4; ++m) _Pragma("unroll") for (int k = 0; k < 2; ++k) dst[m][k] = *(const PG8_LAS bf16x8*)(lds + PG8_SA(b, h) + aoff + m * 2048 + k * 1024); } while (0)
#define PG8_LDB(dst, b, h) do { _Pragma("unroll") for (int n = 0; n < 2; ++n) _Pragma("unroll") for (int k = 0; k < 2; ++k) dst[n][k] = *(const PG8_LAS bf16x8*)(lds + PG8_SB(b, h) + boff + n * 2048 + k * 1024); } while (0)
#define PG8_MMA(ai, bj, At, Bt) do { __builtin_amdgcn_s_setprio(1); _Pragma("unroll") for (int m = 0; m < 4; ++m) _Pragma("unroll") for (int n = 0; n < 2; ++n) _Pragma("unroll") for (int k = 0; k < 2; ++k) \
        acc[ai][bj][m][n] = __builtin_amdgcn_mfma_f32_16x16x32_bf16(Bt[n][k], At[m][k], acc[ai][bj][m][n], 0, 0, 0); __builtin_amdgcn_s_setprio(0); } while (0)
#define PG8_WAIT_V(n) asm volatile("s_waitcnt vmcnt(" #n ")" ::: "memory")
#define PG8_WAIT_L(n) asm volatile("s_waitcnt lgkmcnt(" #n ")" ::: "memory")
#define PG8_BAR __builtin_amdgcn_s_barrier()
#define PG8_SCHED __builtin_amdgcn_sched_barrier(0)
    Unit cur, nxt; int ui = 0;
    if (!S.next(0, cur)) return;
    f32x4 acc[2][2][4][2];
#pragma unroll
    for (int a = 0; a < 2; ++a)
#pragma unroll
        for (int b = 0; b < 2; ++b)
#pragma unroll
            for (int m = 0; m < 4; ++m)
#pragma unroll
                for (int n = 0; n < 2; ++n) acc[a][b][m][n] = (f32x4){0.f, 0.f, 0.f, 0.f};
    bf16x8 At[4][2], B0[2][2], B1[2][2];
    const char* cA = (const char*)g.A + (size_t)cur.pm * tstep; const char* cB = (const char*)g.Bt + (size_t)cur.pn * tstep;
    S.a_ready(cur);
    if constexpr (SP2) {
        PG8_STAGE(PG8_SB(0, 0), cB, voffB); PG8_STAGE(PG8_SB(0, 1), cB + hstep, voffB); PG8_STAGE(PG8_SA(0, 0), cA, voffA); PG8_STAGE(PG8_SA(0, 1), cA + hstep, voffA);
        if (wr == 1) PG8_BAR;
        PG8_WAIT_V(2); PG8_BAR;
        PG8_STAGE(PG8_SB(1, 0), cB + kstep, voffB); PG8_STAGE(PG8_SA(1, 0), cA + kstep, voffA); PG8_STAGE(PG8_SB(1, 1), cB + hstep + kstep, voffB);
        PG8_WAIT_V(6); PG8_BAR;
    } else {
        PG8_STAGE(PG8_SB(0, 0), cB, voffB); PG8_STAGE(PG8_SA(0, 0), cA, voffA); PG8_STAGE(PG8_SB(0, 1), cB + hstep, voffB); PG8_STAGE(PG8_SA(0, 1), cA + hstep, voffA);
        if (wr == 1) PG8_BAR;
        PG8_WAIT_V(4); PG8_BAR;
        PG8_STAGE(PG8_SB(1, 0), cB + kstep, voffB); PG8_STAGE(PG8_SA(1, 0), cA + kstep, voffA); PG8_STAGE(PG8_SB(1, 1), cB + hstep + kstep, voffB);
        PG8_WAIT_V(6); PG8_BAR;
    }
    for (;;) {
        const bool has_next = S.next(ui + 1, nxt);
        typename Epi::Pre pre; E.prefetch(pre, cur, wr, fr);
        const char* nA = has_next ? (const char*)g.A + (size_t)nxt.pm * tstep : cA; const char* nB = has_next ? (const char*)g.Bt + (size_t)nxt.pn * tstep : cB;
        for (int t = 0; t < nt; t += 2) {
            const bool last = (t == nt - 2);
            const char* a1 = cA + (size_t)(t + 1) * kstep;
            const char* a2 = last ? nA : cA + (size_t)(t + 2) * kstep; const char* b2 = last ? nB : cB + (size_t)(t + 2) * kstep;
            const char* a3 = a2 + kstep; const char* b3 = b2 + kstep;
            if (last && has_next) S.a_ready(nxt);
            if constexpr (SP2) {
            PG8_LDB(B0, 0, 0); PG8_LDB(B1, 0, 1); PG8_SCHED; PG8_LDA(At, 0, 0); PG8_STAGE(PG8_SA(1, 1), a1 + hstep, voffA);
            PG8_WAIT_V(8); PG8_WAIT_L(0); PG8_BAR; PG8_MMA(0, 0, At, B0); PG8_MMA(0, 1, At, B1); PG8_BAR; PG8_SCHED;
            PG8_LDA(At, 0, 1); PG8_STAGE(PG8_SB(0, 0), b2, voffB); PG8_STAGE(PG8_SB(0, 1), b2 + hstep, voffB); PG8_STAGE(PG8_SA(0, 0), a2, voffA);
            PG8_WAIT_V(8); PG8_WAIT_L(0); PG8_BAR; PG8_MMA(1, 0, At, B0); PG8_MMA(1, 1, At, B1); PG8_BAR; PG8_SCHED;
            PG8_LDB(B0, 1, 0); PG8_LDB(B1, 1, 1); PG8_SCHED; PG8_LDA(At, 1, 0); PG8_STAGE(PG8_SA(0, 1), a2 + hstep, voffA);
            PG8_WAIT_V(8); PG8_WAIT_L(0); PG8_BAR; PG8_MMA(0, 0, At, B0); PG8_MMA(0, 1, At, B1); PG8_BAR; PG8_SCHED;
            PG8_LDA(At, 1, 1); PG8_STAGE(PG8_SB(1, 0), b3, voffB); PG8_STAGE(PG8_SB(1, 1), b3 + hstep, voffB); PG8_STAGE(PG8_SA(1, 0), a3, voffA);
            PG8_WAIT_V(8); PG8_WAIT_L(0); PG8_BAR; PG8_MMA(1, 0, At, B0); PG8_MMA(1, 1, At, B1); PG8_BAR; PG8_SCHED;
            } else {
            PG8_LDB(B0, 0, 0); PG8_SCHED; PG8_LDA(At, 0, 0); PG8_STAGE(PG8_SA(1, 1), a1 + hstep, voffA);
            PG8_WAIT_L(8); PG8_BAR; PG8_WAIT_L(0); PG8_MMA(0, 0, At, B0); PG8_BAR; PG8_SCHED;
            PG8_LDB(B1, 0, 1); PG8_STAGE(PG8_SB(0, 0), b2, voffB);
            PG8_BAR; PG8_WAIT_L(0); PG8_MMA(0, 1, At, B1); PG8_BAR;
            PG8_LDA(At, 0, 1); PG8_STAGE(PG8_SA(0, 0), a2, voffA);
            PG8_BAR; PG8_WAIT_L(0); PG8_MMA(1, 0, At, B0); PG8_BAR; PG8_SCHED;
            PG8_STAGE(PG8_SB(0, 1), b2 + hstep, voffB);
            PG8_WAIT_V(6); PG8_BAR; PG8_MMA(1, 1, At, B1); PG8_BAR;
            PG8_LDB(B0, 1, 0); PG8_SCHED; PG8_LDA(At, 1, 0); PG8_STAGE(PG8_SA(0, 1), a2 + hstep, voffA);
            PG8_WAIT_L(8); PG8_BAR; PG8_WAIT_L(0); PG8_MMA(0, 0, At, B0); PG8_BAR; PG8_SCHED;
            PG8_LDB(B1, 1, 1); PG8_STAGE(PG8_SB(1, 0), b3, voffB);
            PG8_BAR; PG8_WAIT_L(0); PG8_MMA(0, 1, At, B1); PG8_BAR;
            PG8_LDA(At, 1, 1); PG8_STAGE(PG8_SA(1, 0), a3, voffA);
            PG8_BAR; PG8_WAIT_L(0); PG8_MMA(1, 0, At, B0); PG8_BAR; PG8_SCHED;
            PG8_STAGE(PG8_SB(1, 1), b3 + hstep, voffB);
            PG8_WAIT_V(6); PG8_BAR; PG8_MMA(1, 1, At, B1); PG8_BAR;
            }
        }
        if constexpr (ALIGN_EPI) { if (wr == 0) PG8_BAR; }
        if constexpr (!Epi::AFTER_DRAIN) { E(acc, cur, wr, wc, fr, fq, pre); S.done(cur); }
        if (!has_next) break;
#pragma unroll
        for (int a = 0; a < 2; ++a)
#pragma unroll
            for (int b = 0; b < 2; ++b)
#pragma unroll
                for (int m = 0; m < 4; ++m)
#pragma unroll
                    for (int n = 0; n < 2; ++n) acc[a][b][m][n] = (f32x4){0.f, 0.f, 0.f, 0.f};
        cur = nxt; cA = nA; cB = nB; ++ui;
        if constexpr (ALIGN_EPI) { if (wr == 1) PG8_BAR; }
    }
    PG8_WAIT_V(0);
    if constexpr (!ALIGN_EPI) { if (wr == 0) PG8_BAR; }
    PG8_BAR;
    if constexpr (Epi::AFTER_DRAIN) { E.fused(acc, cur, wr, wc, fr, fq, lds, wid, lane); S.done(cur); }
#undef PG8_SA
#undef PG8_SB
#undef PG8_STAGE
#undef PG8_LDA
#undef PG8_LDB
#undef PG8_MMA
#undef PG8_WAIT_V
#undef PG8_WAIT_L
#undef PG8_BAR
#undef PG8_SCHED
}
}
#ifndef MK_N_LAUNCHES
#define MK_N_LAUNCHES 1
#endif
constexpr int NWAVES = 8;
constexpr int N_PHASES = 8;
using pg8::TP; using pg8::NSMP; using pg8::MV; using pg8::MP; using pg8::DM; using pg8::N1; using pg8::NFF; using pg8::NGU; using pg8::LOG2E; using pg8::EPS;
using pg8::O_Y; using pg8::O_KWP; using pg8::O_VWP; using pg8::O_SP; using pg8::O_KWS; using pg8::O_VWS; using pg8::O_SS;

constexpr size_t MiB = 1u << 20;
constexpr size_t WS_CTL = 0, CTL_ZERO_BYTES = 64 * 1024;
constexpr size_t WS_W1T = 1 * MiB, WS_WOT = 6 * MiB, WS_WGUT = 8 * MiB, WS_WDT = 19 * MiB;
constexpr size_t WS_RSTD = 25 * MiB, WS_BT2 = 25 * MiB + 128 * 1024, WS_LR = 238 * MiB, WS_SS2 = 27 * MiB + 512 * 1024;
constexpr size_t WS_XB = 29 * MiB;
constexpr size_t WS_QKV = 62 * MiB;
constexpr size_t WS_GQ = 87 * MiB, WS_GK = 96 * MiB, WS_GV = 105 * MiB, WS_GR = 122 * MiB;
constexpr size_t WS_MIX = 139 * MiB;
constexpr size_t WS_HB = 172 * MiB;
constexpr size_t WS_HID = 29 * MiB;
constexpr size_t WS_GQT = 220 * MiB, WS_GKT = 229 * MiB;
constexpr size_t WS_SS2S = 219 * MiB;
constexpr size_t WS_BTL = 218 * MiB;
constexpr size_t WS_U = 205 * MiB, WS_SC = 213 * MiB, WS_DCH = 217 * MiB;
constexpr size_t WS_END = 256 * MiB;
static_assert(WS_HID + (size_t)MP * NFF * 2 <= WS_GR && WS_GR + (size_t)MP * 512 * 2 <= WS_MIX && WS_MIX + (size_t)MP * DM * 2 <= WS_HB && WS_HB + (size_t)MP * DM * 2 <= WS_END, "ws map");
static_assert(WS_XB + (size_t)MP * DM * 2 <= WS_QKV && WS_QKV + (size_t)MP * 768 * 2 <= WS_GQ && WS_GQ + (size_t)MP * 512 <= WS_GK && WS_GK + (size_t)MP * 512 <= WS_GV && WS_GV + (size_t)MP * 1024 <= WS_GR, "ws map 2");
static_assert(WS_W1T + (size_t)N1 * DM * 2 <= WS_WOT && WS_WGUT + (size_t)NGU * DM * 2 <= WS_WDT && WS_WDT + (size_t)DM * NFF * 2 <= WS_RSTD && WS_LR + (size_t)MP * 1024 <= WS_END && WS_SS2 + (size_t)MP * 64 <= WS_XB, "ws map 3");
constexpr int CW_BAR = 1024;

constexpr int RING_OFF = 0, RING_BYTES = 131072;
constexpr int LDSCTL_OFF = RING_BYTES, MISC_OFF = LDSCTL_OFF + 320;
constexpr int LDS_BYTES = 147456;

#define GAS __attribute__((address_space(1)))
#define LAS __attribute__((address_space(3)))
typedef unsigned short bf16;
typedef unsigned v4u __attribute__((ext_vector_type(4)));
typedef unsigned u32x2 __attribute__((ext_vector_type(2)));
typedef float f32x4 __attribute__((ext_vector_type(4)));
typedef GAS unsigned gu32;
#define RLX_AGENT __ATOMIC_RELAXED, __HIP_MEMORY_SCOPE_AGENT
#define LDS_WAIT() asm volatile("s_waitcnt lgkmcnt(0)" ::: "memory")
typedef float f32x2_t __attribute__((ext_vector_type(2))); typedef __bf16 bf16x2_t __attribute__((ext_vector_type(2)));
__device__ __forceinline__ unsigned pk2(float lo, float hi) { const f32x2_t v = {lo, hi}; const bf16x2_t b = __builtin_convertvector(v, bf16x2_t); return __builtin_bit_cast(unsigned, b); }
__device__ __forceinline__ unsigned f2bf(float f) { return pk2(f, 0.f) & 0xffffu; }
__device__ __forceinline__ float bf2f(unsigned b) { return __uint_as_float(b << 16); }
__device__ __forceinline__ float bflo(unsigned w) { return __uint_as_float(w << 16); }
__device__ __forceinline__ float bfhi(unsigned w) { return __uint_as_float(w & 0xffff0000u); }

#define XB_TMO      128
#define XB_XCNT(j)  (256  + 64 * (j))
#define XB_XSUB(j)  (1280 + 64 * (j))
#define XB_XGEN(j)  (2304 + 64 * (j))
#define XB_TOP      3328
#define XB_TOPGEN   3392
#define XCD_BAR_WORDS 3456
#define XB_SPIN_CAP (1u << 18)
__device__ __forceinline__ unsigned xb_ld(unsigned* p)              { return __hip_atomic_load(p, __ATOMIC_RELAXED, __HIP_MEMORY_SCOPE_AGENT); }
__device__ __forceinline__ unsigned xb_add(unsigned* p, unsigned v) { return __hip_atomic_fetch_add(p, v, __ATOMIC_RELAXED, __HIP_MEMORY_SCOPE_AGENT); }
__device__ __forceinline__ unsigned xb_xcc_id() { return (unsigned)__builtin_amdgcn_s_getreg((3 << 11) | 20) & 0xFu; }
#define XB_SPIN(cond, bar) do { unsigned _sp = 0; while (cond) { __builtin_amdgcn_s_sleep(1); \
    if ((++_sp & 255u) == 0u) { if (xb_ld(&(bar)[XB_TMO])) break; if (_sp > XB_SPIN_CAP) { atomicAdd(&(bar)[XB_TMO], 1u); break; } } } } while (0)
struct XcdBarrier { unsigned* bar; unsigned x; volatile LAS unsigned* st; };
__device__ __forceinline__ XcdBarrier xcd_barrier_post(unsigned* bar, volatile LAS unsigned* st) {
    XcdBarrier b; b.bar = bar; b.x = xb_xcc_id(); b.st = st;
    if (threadIdx.x == 0) (void)xb_add(&bar[XB_XCNT(b.x)], 1u);
    return b;
}
__device__ __forceinline__ void xcd_barrier_complete(unsigned* bar, unsigned x, unsigned& nloc, unsigned& nx) {
    const unsigned G = gridDim.x * gridDim.y * gridDim.z;
    unsigned sum, cnt, mine, sp = 0u;
    for (;;) {
        sum = 0u; cnt = 0u; mine = 0u;
#pragma unroll
        for (unsigned j = 0; j < 16; ++j) { const unsigned c = xb_ld(&bar[XB_XCNT(j)]); sum += c; cnt += (c > 0u) ? 1u : 0u; mine = (j == x) ? c : mine; }
        if (sum == G) break;
        __builtin_amdgcn_s_sleep(1);
        if ((++sp & 255u) == 0u) { if (xb_ld(&bar[XB_TMO])) break; if (sp > XB_SPIN_CAP) { atomicAdd(&bar[XB_TMO], 1u); break; } }
    }
    nloc = mine > 0u ? mine : 1u; nx = cnt > 0u ? cnt : 1u;
}
__device__ __attribute__((noinline)) void xcd_barrier(XcdBarrier b) {
    asm volatile("s_waitcnt vmcnt(0)" ::: "memory");
    __syncthreads();
    if (threadIdx.x == 0) {
        unsigned* bar = b.bar;
        __builtin_amdgcn_s_waitcnt(0);
        unsigned nloc = b.st[0], nx = b.st[1];
        if (nloc == 0u) { xcd_barrier_complete(bar, b.x, nloc, nx); b.st[0] = nloc; b.st[1] = nx; }
        const unsigned old = xb_add(&bar[XB_XSUB(b.x)], 1u);
        const unsigned gen = old / nloc;
        if (old + 1u == (gen + 1u) * nloc) {
            __builtin_amdgcn_fence(__ATOMIC_RELEASE, "agent");
            asm volatile("s_waitcnt vmcnt(0)" ::: "memory");
            const unsigned og = xb_add(&bar[XB_TOP], 1u);
            const unsigned tg = og / nx;
            if (og + 1u == (tg + 1u) * nx) xb_add(&bar[XB_TOPGEN], 1u);
            else XB_SPIN(xb_ld(&bar[XB_TOPGEN]) == tg, bar);
            __builtin_amdgcn_fence(__ATOMIC_ACQUIRE, "agent");
            xb_add(&bar[XB_XGEN(b.x)], 1u);
            asm volatile("s_waitcnt vmcnt(0)" ::: "memory");
        } else {
            XB_SPIN(xb_ld(&bar[XB_XGEN(b.x)]) == gen, bar);
            __builtin_amdgcn_fence(__ATOMIC_ACQUIRE, "agent");
            asm volatile("s_waitcnt vmcnt(0)" ::: "memory");
        }
    }
    __syncthreads();
}

struct Args { const float* in[19]; float* out; unsigned char* ws; int ph_lo, ph_hi; };
struct Frame {
    LAS unsigned char* lds; int tid, lane, wave, G, bid;
    const float *xp, *xs, *ck, *cv, *sg, *ang, *w_in, *qng, *kng, *sinks, *relb, *w2, *bg, *glg, *w_o, *fng, *w_gate, *w_up, *w_down;
    float* out; unsigned char* ws;
    bf16 *W1T, *WOT, *WGUT, *WDT, *XB, *QKV, *GQ, *GK, *GV, *GR, *MIX, *HB, *HID;
    float *RSTD, *BT2, *BTL, *SS2, *SS2S, *U, *DCH; bf16* LR; bf16 *SC, *GQT, *GKT;
};

__device__ __forceinline__ float wave_sum(float v) {
#pragma unroll
    for (int o = 1; o < 64; o <<= 1) v += __shfl_xor(v, o);
    return v;
}
__device__ __forceinline__ float wave_max(float v) {
#pragma unroll
    for (int o = 1; o < 64; o <<= 1) v = fmaxf(v, __shfl_xor(v, o));
    return v;
}

__device__ __forceinline__ int w1_srccol(int n) {
    const int t = n >> 8, s = n & 255;
    if (t < 3) { const int bj = s >> 7, wc = (s >> 5) & 3, j = s & 31; return (4 * t + wc) * 64 + bj * 32 + j; }
    if (t < 9) return 768 + (t - 3) * 256 + s;
    return -2;
}
__device__ __forceinline__ int wgu_srccol(int n) { const int t = n >> 8, s = n & 255; return (s < 128) ? 128 * t + s : NFF + 128 * t + (s - 128); }
__device__ __forceinline__ void conv_item(const float* src, int ld, int col, bool valid, const float* scale, int K, bf16* dst, int n0, int k0, LAS float* scr, int lane) {
    float v[32];
#pragma unroll
    for (int i = 0; i < 32; ++i) { const int kk = 2 * i + (lane >> 5); v[i] = valid ? __builtin_nontemporal_load(src + (size_t)(k0 + kk) * ld + col) : 0.f; }
    if (scale) {
#pragma unroll
        for (int i = 0; i < 32; ++i) v[i] *= scale[k0 + 2 * i + (lane >> 5)]; }
#pragma unroll
    for (int i = 0; i < 32; ++i) scr[(2 * i + (lane >> 5)) * 33 + (lane & 31)] = v[i];
    LDS_WAIT(); asm volatile("" ::: "memory");
    const int c = lane & 7;
#pragma unroll
    for (int j = 0; j < 4; ++j) { const int n = (lane >> 3) + 8 * j; const LAS float* s = scr + (8 * c) * 33 + n;
        v4u o; o.x = pk2(s[0 * 33], s[1 * 33]); o.y = pk2(s[2 * 33], s[3 * 33]); o.z = pk2(s[4 * 33], s[5 * 33]); o.w = pk2(s[6 * 33], s[7 * 33]);
        *(GAS v4u*)(dst + (size_t)(n0 + n) * K + k0 + 8 * c) = o; }
    LDS_WAIT(); asm volatile("" ::: "memory");
}
__device__ __forceinline__ int t5_bucket(int n) {
    if (n < 16) return n;
    const int l = 16 + (int)(logf((float)n / 16.f) / 2.0794415416798357f * 16.f);
    return l < 31 ? l : 31;
}
template <int PART>
__device__ __forceinline__ void p_chores(Frame& F, int wk, int nwk) {
    LAS float* scr = (LAS float*)(F.lds + RING_OFF + F.wave * 16384);
    const int gw = wk * NWAVES + F.wave, NGW = nwk * NWAVES;
    constexpr int IO = 16 * 32, IGU = 16 * (NGU / 32), ID = (NFF / 64) * 32;
    if (PART == 0) {
        for (int it = gw; it < IO + IGU; it += NGW) {
            int r = it;
            if (r < IO) { const int nb = r % 32, kb = r / 32; conv_item(F.w_o, DM, 32 * nb + (F.lane & 31), true, nullptr, DM, F.WOT, 32 * nb, 64 * kb, scr, F.lane); continue; } r -= IO;
            { const int nb = r % (NGU / 32), kb = r / (NGU / 32); const int sc = wgu_srccol(32 * nb + (F.lane & 31));
              const bool up = sc >= NFF; conv_item(up ? F.w_up : F.w_gate, NFF, up ? sc - NFF : sc, true, F.fng, DM, F.WGUT, 32 * nb, 64 * kb, scr, F.lane); }
        }
    }
    if (PART == 0 || PART == 1) for (int it = gw; it < ID; it += NGW) { const int nb = it % 32, kb = it / 32; conv_item(F.w_down, DM, 32 * nb + (F.lane & 31), true, nullptr, NFF, F.WDT, 32 * nb, 64 * kb, scr, F.lane); }
}
__device__ __forceinline__ void p0_prologue(Frame& F) {
    LAS float* scr = (LAS float*)(F.lds + RING_OFF + F.wave * 16384);
    const int gw = F.bid * NWAVES + F.wave, NGW = F.G * NWAVES;
    constexpr int I1 = 16 * (N1 / 32);
    for (int it = gw; it < I1; it += NGW) { const int nb = it % (N1 / 32), kb = it / (N1 / 32); const int n = 32 * nb + (F.lane & 31); const int col = w1_srccol(n);
        if (col != -2) conv_item(F.w_in, 2320, col, col >= 0, F.ang, DM, F.W1T, 32 * nb, 64 * kb, scr, F.lane); }
    {
        const int gt = F.bid * (NWAVES * 64) + F.tid, NGT = F.G * NWAVES * 64;
        for (int i = gt; i < 256 * 128; i += NGT) { const int c = i >> 7, k0 = (i & 127) * 8;
            float w2c[16];
#pragma unroll
            for (int r = 0; r < 16; ++r) w2c[r] = F.w2[r * 256 + c];
            float o[8];
#pragma unroll
            for (int kk = 0; kk < 8; ++kk) { const f32x4* wr = (const f32x4*)(F.w_in + (size_t)(k0 + kk) * 2320 + 2304); float s = 0.f;
#pragma unroll
                for (int r4 = 0; r4 < 4; ++r4) { const f32x4 l = wr[r4]; s += l[0] * w2c[4 * r4] + l[1] * w2c[4 * r4 + 1] + l[2] * w2c[4 * r4 + 2] + l[3] * w2c[4 * r4 + 3]; }
                o[kk] = s * F.ang[k0 + kk]; }
            v4u ov; ov.x = pk2(o[0], o[1]); ov.y = pk2(o[2], o[3]); ov.z = pk2(o[4], o[5]); ov.w = pk2(o[6], o[7]);
            *(GAS v4u*)(F.W1T + (size_t)(2304 + c) * DM + k0) = ov; }
        for (int i = gt; i < 8 * 5 * 4 * 64 * 4; i += NGT) { const int e = i & 3, ln = (i >> 2) & 63, r4 = (i >> 8) & 3, hd5 = i >> 10, di = hd5 % 5, h = hd5 / 5;
            const int r = 4 * r4 + e, kl = (r & 3) + 8 * (r >> 2) + 4 * (ln >> 5), dist = 128 - 32 * di + (ln & 31) - kl;
            F.BTL[i] = (dist >= 0 && dist < 128) ? F.relb[t5_bucket(dist) * 8 + h] * LOG2E : -INFINITY; }
        if (F.bid == 0) for (int i = F.tid; i < 8 * 128; i += NWAVES * 64) { const int h = i >> 7, d = i & 127; F.BT2[i] = F.relb[t5_bucket(d) * 8 + h] * LOG2E; }
    }
    for (int m0 = 2 * gw; m0 < MP; m0 += 2 * NGW) {
        f32x4 v[2][4];
#pragma unroll
        for (int rr = 0; rr < 2; ++rr) { const int m = m0 + rr;
            if (m < MV) { const float* xrow = m < TP ? F.xp + (size_t)m * DM : F.xs + (size_t)(m - TP) * DM; const GAS f32x4* xr = (const GAS f32x4*)xrow + F.lane;
#pragma unroll
                for (int j = 0; j < 4; ++j) v[rr][j] = __builtin_nontemporal_load(xr + 64 * j); }
            else {
#pragma unroll
                for (int j = 0; j < 4; ++j) v[rr][j] = (f32x4){0.f, 0.f, 0.f, 0.f}; } }
#pragma unroll
        for (int rr = 0; rr < 2; ++rr) { const int m = m0 + rr; float s = 0.f;
#pragma unroll
            for (int j = 0; j < 4; ++j) s += (v[rr][j].x * v[rr][j].x + v[rr][j].y * v[rr][j].y) + (v[rr][j].z * v[rr][j].z + v[rr][j].w * v[rr][j].w);
            s = wave_sum(s);
            if (F.lane == 0) { F.RSTD[m] = m < MV ? rsqrtf(s * (1.f / DM) + EPS) : 0.f; F.SS2[m] = 0.f; }
            GAS unsigned long long* o8 = (GAS unsigned long long*)(F.XB + (size_t)m * DM) + F.lane;
#pragma unroll
            for (int j = 0; j < 4; ++j) o8[64 * j] = (unsigned long long)pk2(v[rr][j].x, v[rr][j].y) | ((unsigned long long)pk2(v[rr][j].z, v[rr][j].w) << 32); }
    }
}

__device__ __forceinline__ void unpack8(const v4u w, float* q) { q[0] = bflo(w.x); q[1] = bfhi(w.x); q[2] = bflo(w.y); q[3] = bfhi(w.y); q[4] = bflo(w.z); q[5] = bfhi(w.z); q[6] = bflo(w.w); q[7] = bfhi(w.w); }
__device__ __forceinline__ float dot64_bf(const float* q, const bf16* k) {
    float s = 0.f;
#pragma unroll
    for (int c = 0; c < 8; ++c) { const v4u w = *(const v4u*)(k + 8 * c); float kk[8]; unpack8(w, kk);
#pragma unroll
        for (int e = 0; e < 8; ++e) s += q[8 * c + e] * kk[e]; }
    return s;
}
__device__ __forceinline__ float dot64_f(const float* q, const float* k) {
    float s = 0.f;
#pragma unroll
    for (int c = 0; c < 16; ++c) { const f32x4 w = *(const f32x4*)(k + 4 * c);
#pragma unroll
        for (int e = 0; e < 4; ++e) s += q[4 * c + e] * w[e]; }
    return s;
}
__device__ __forceinline__ float log_alpha(float z) { return (fminf(z, 0.f) - __logf(1.f + __expf(-fabsf(z)))) * 0.0625f; }
__device__ __forceinline__ void gla_sample(Frame& F) {
    LAS float* oP = (LAS float*)(F.lds + RING_OFF);
    const int w = F.wave, lane = F.lane, ts = w >> 2, qd = w & 3, dv4 = lane & 31, r2 = lane >> 5;
    for (int it = F.bid; it < NSMP * 2; it += F.G) {
        const int task = 2 * it + ts, b = task >> 2, hd = task & 3, row = TP + b;
        const float* S0 = F.sg + ((size_t)(b * 4 + hd) * 64) * 128 + 4 * dv4;
        float* S1 = F.out + O_SS + ((size_t)(b * 4 + hd) * 64) * 128 + 4 * dv4;
        f32x4 s[8]; float a[8], k[8], q[8];
#pragma unroll
        for (int i = 0; i < 8; ++i) { const int dk = 16 * qd + 2 * i + r2, c = hd * 64 + dk; s[i] = __builtin_nontemporal_load((const f32x4*)(S0 + dk * 128));
            a[i] = bf2f(F.LR[(size_t)row * 256 + c]); k[i] = bf2f(F.GK[(size_t)row * 256 + c]); q[i] = bf2f(F.GQ[(size_t)row * 256 + c]); }
        const u32x2 vv = *(const u32x2*)(F.GV + (size_t)row * 512 + hd * 128 + 4 * dv4);
        const f32x4 v = {bflo(vv.x), bfhi(vv.x), bflo(vv.y), bfhi(vv.y)};
        f32x4 o4 = {0.f, 0.f, 0.f, 0.f};
#pragma unroll
        for (int i = 0; i < 8; ++i) { const int dk = 16 * qd + 2 * i + r2; const f32x4 sn = s[i] * __expf(a[i]) + v * k[i]; __builtin_nontemporal_store(sn, (f32x4*)(S1 + dk * 128)); o4 = o4 + sn * q[i]; }
#pragma unroll
        for (int e = 0; e < 4; ++e) o4[e] += __shfl_xor(o4[e], 32);
        if (r2 == 0) *(LAS f32x4*)(oP + (ts * 4 + qd) * 128 + 4 * dv4) = o4;
        __syncthreads();
        if (qd == 0) {
            const LAS float* p = oP + ts * 512;
            const float o0 = (p[lane] + p[128 + lane]) + (p[256 + lane] + p[384 + lane]), o1 = (p[64 + lane] + p[192 + lane]) + (p[320 + lane] + p[448 + lane]);
            const float rs = rsqrtf(wave_sum(o0 * o0 + o1 * o1) * (1.f / 128.f) + EPS);
            const bf16* gr = F.GR + (size_t)row * 512 + hd * 128; bf16* mx = F.MIX + (size_t)row * DM + 512 + hd * 128;
            mx[lane] = (bf16)f2bf(o0 * rs * F.glg[lane] * bf2f(gr[lane]));
            mx[64 + lane] = (bf16)f2bf(o1 * rs * F.glg[64 + lane] * bf2f(gr[64 + lane]));
        }
        __syncthreads();
    }
}
typedef short bf16x8 __attribute__((ext_vector_type(8)));
typedef short v4i16_t __attribute__((ext_vector_type(4)));
typedef float f32x16 __attribute__((ext_vector_type(16)));
constexpr int NCH = TP / 256;
constexpr int GL_V = 0, GL_KH = 65536, GL_LR = 98304, GL_TOT = 114688;
constexpr int GC_V = 0, GC_S = 65536, GC_KT = 98304;
__device__ __forceinline__ int crow(int r, int hi) { return (r & 3) + 8 * (r >> 2) + 4 * hi; }
__device__ __forceinline__ bf16x8 tr_frag(const LAS unsigned char* p0, const LAS unsigned char* p1) {
    const v4i16_t lo = __builtin_amdgcn_ds_read_tr16_b64_v4i16((LAS v4i16_t*)p0), hi = __builtin_amdgcn_ds_read_tr16_b64_v4i16((LAS v4i16_t*)p1);
    return (bf16x8){lo[0], lo[1], lo[2], lo[3], hi[0], hi[1], hi[2], hi[3]};
}
__device__ __forceinline__ int img256(int row, int col) { return row * 256 + ((((col >> 5) ^ (row & 3))) << 6) + ((col & 31) << 1); }
__device__ __forceinline__ int img128t(int row, int col) { return (row >> 1) * 256 + (((((row & 1) << 1) + (col >> 5)) ^ ((row >> 1) & 1)) << 6) + ((col & 31) << 1); }
__device__ __forceinline__ void stage_v_img(Frame& F, int t0, int hd, LAS unsigned char* img) {
#pragma unroll
    for (int i = 0; i < 8; ++i) { const int piece = F.tid + 512 * i, row = piece >> 4, ch = piece & 15;
        const v4u v = *(const v4u*)(F.GV + (size_t)(t0 + row) * 512 + hd * 128 + ch * 8);
        *(LAS v4u*)(img + row * 256 + ((((ch >> 2) ^ (row & 3))) << 6) + ((ch & 3) << 4)) = v; }
}
__device__ __forceinline__ void gla_a_unit(Frame& F, int c, int hd, bool keep) {
    LAS unsigned char* L = F.lds + RING_OFF;
    LAS float* BIMG = (LAS float*)L; LAS float* TOT = (LAS float*)(F.lds + LDSCTL_OFF + 2048); LAS float* EBT = (LAS float*)(F.lds + LDSCTL_OFF + 4096);
    int tid_ = F.tid; asm volatile("" : "+v"(tid_));
    const int w = F.wave, lane = tid_ & 63, t0 = 256 * c, cc = hd * 64 + lane;
    v4u vreg[8];
#pragma unroll
    for (int i = 0; i < 8; ++i) { const int piece = tid_ + 512 * i, row = piece >> 4, ch = piece & 15; vreg[i] = __builtin_nontemporal_load((const v4u*)(F.GV + (size_t)(t0 + row) * 512 + hd * 128 + ch * 8)); }
    float bl[32]; float run = 0.f;
#pragma unroll
    for (int i = 0; i < 32; ++i) bl[i] = bf2f(__builtin_nontemporal_load(F.LR + (size_t)(t0 + 32 * w + i) * 256 + cc));
#pragma unroll
    for (int i = 0; i < 32; ++i) { run += bl[i]; bl[i] = run; }
    TOT[w * 64 + lane] = run;
    __syncthreads();
    float off = 0.f, btot = 0.f;
#pragma unroll
    for (int ww = 0; ww < 8; ++ww) { const float v = TOT[ww * 64 + lane]; btot += v; if (ww < w) off += v; }
#pragma unroll
    for (int i = 0; i < 32; ++i) BIMG[(32 * w + i) * 64 + lane] = bl[i] + off;
    if (w == 0) { const float ebt = __expf(btot); EBT[lane] = ebt; F.DCH[(c * 4 + hd) * 64 + lane] = ebt; }
    __syncthreads();
    v4u q8v[4], k8v[4];
#pragma unroll
    for (int j = 0; j < 4; ++j) { const int it = tid_ + 512 * j, t = it >> 3, ch = it & 7; const size_t gi = (size_t)(t0 + t) * 256 + hd * 64 + ch * 8;
        q8v[j] = __builtin_nontemporal_load((const v4u*)(F.GQ + gi)); k8v[j] = __builtin_nontemporal_load((const v4u*)(F.GK + gi)); }
#pragma unroll
    for (int j = 0; j < 4; ++j) { const int it = tid_ + 512 * j, t = it >> 3, ch = it & 7; const size_t gi = (size_t)(t0 + t) * 256 + hd * 64 + ch * 8;
        const v4u q8 = q8v[j], k8 = k8v[j];
        const f32x4 b0 = *(const LAS f32x4*)(BIMG + t * 64 + ch * 8), b1 = *(const LAS f32x4*)(BIMG + t * 64 + ch * 8 + 4);
        const f32x4 e0 = *(const LAS f32x4*)(EBT + ch * 8), e1 = *(const LAS f32x4*)(EBT + ch * 8 + 4);
        float qv[8], kv[8], bb[8], ee[8]; unpack8(q8, qv); unpack8(k8, kv);
#pragma unroll
        for (int e = 0; e < 4; ++e) { bb[e] = b0[e]; bb[4 + e] = b1[e]; ee[e] = e0[e]; ee[4 + e] = e1[e]; }
        float qt[8], kt[8], kh[8];
#pragma unroll
        for (int e = 0; e < 8; ++e) { const float eb = __builtin_amdgcn_exp2f(bb[e] * LOG2E); kt[e] = kv[e] * __builtin_amdgcn_rcpf(eb); qt[e] = qv[e] * eb; kh[e] = kt[e] * ee[e]; }
        v4u o; o.x = pk2(qt[0], qt[1]); o.y = pk2(qt[2], qt[3]); o.z = pk2(qt[4], qt[5]); o.w = pk2(qt[6], qt[7]); *(v4u*)(F.GQT + gi) = o;
        o.x = pk2(kt[0], kt[1]); o.y = pk2(kt[2], kt[3]); o.z = pk2(kt[4], kt[5]); o.w = pk2(kt[6], kt[7]); *(LAS v4u*)(L + GC_KT + t * 128 + ((ch ^ (t & 7)) << 4)) = o; if (!keep) *(v4u*)(F.GKT + gi) = o;
        o.x = pk2(kh[0], kh[1]); o.y = pk2(kh[2], kh[3]); o.z = pk2(kh[4], kh[5]); o.w = pk2(kh[6], kh[7]); *(LAS v4u*)(L + GL_KH + img128t(t, ch * 8)) = o; }
    __syncthreads();
#pragma unroll
    for (int i = 0; i < 8; ++i) { const int piece = tid_ + 512 * i, row = piece >> 4, ch = piece & 15; *(LAS v4u*)(L + GL_V + row * 256 + ((((ch >> 2) ^ (row & 3))) << 6) + ((ch & 3) << 4)) = vreg[i]; }
    __syncthreads();
    const int kt = w & 1, dt = w >> 1, hi = lane >> 5, g1 = (lane >> 4) & 1, q4 = (lane & 15) >> 2, p4 = lane & 3;
    f32x16 acc = {};
#pragma unroll 4
    for (int st = 0; st < 16; ++st) { const int r0 = 16 * st + 8 * hi + q4;
        const bf16x8 a = tr_frag(L + GL_KH + img128t(r0, 32 * kt + 16 * g1 + 4 * p4), L + GL_KH + img128t(r0 + 4, 32 * kt + 16 * g1 + 4 * p4));
        const bf16x8 b = tr_frag(L + GL_V + img256(r0, 32 * dt + 16 * g1 + 4 * p4), L + GL_V + img256(r0 + 4, 32 * dt + 16 * g1 + 4 * p4));
        acc = __builtin_amdgcn_mfma_f32_32x32x16_bf16(a, b, acc, 0, 0, 0); }
    float* up = F.U + ((size_t)(c * 4 + hd) * 64 + 32 * kt) * 128 + 32 * dt + (lane & 31);
#pragma unroll
    for (int r = 0; r < 16; ++r) up[crow(r, hi) * 128] = acc[r];
    __syncthreads();
}
__device__ __forceinline__ void gla_scan(Frame& F) {
    for (int wv = F.bid * NWAVES + F.wave; wv < 512; wv += F.G * NWAVES) {
        const int id = wv * 64 + F.lane;
        const int hdk = id >> 7;
        float u[NCH], d[NCH];
#pragma unroll
        for (int c = 0; c < NCH; ++c) u[c] = __builtin_nontemporal_load(F.U + (size_t)c * 32768 + id);
#pragma unroll
        for (int c = 0; c < NCH; ++c) d[c] = F.DCH[c * 256 + hdk];
        float S = 0.f;
#pragma unroll
        for (int c = 0; c < NCH; ++c) { F.SC[(size_t)c * 32768 + id] = (bf16)f2bf(S); S = d[c] * S + u[c]; }
        F.out[O_SP + id] = S;
    }
}
__device__ __forceinline__ void gla_c_unit(Frame& F, int c, int hd, bool keep, const unsigned* sflag, unsigned starget) {
    LAS unsigned char* L = F.lds + RING_OFF;
    const int w = F.wave, lane = F.lane, t0 = 256 * c, tt = (w < 4) ? w : 11 - w;
    const int hi = lane >> 5, l31 = lane & 31, g1 = (lane >> 4) & 1, q4 = (lane & 15) >> 2, p4 = lane & 3;
    if (!keep) {
#pragma unroll
    for (int i = 0; i < 4; ++i) { const int piece = F.tid + 512 * i, row = piece >> 3, ch = piece & 7;
        *(LAS v4u*)(L + GC_KT + row * 128 + ((ch ^ (row & 7)) << 4)) = *(const v4u*)(F.GKT + (size_t)(t0 + row) * 256 + hd * 64 + ch * 8); }
    stage_v_img(F, t0, hd, L + GC_V);
    }
    bf16x8 qf[4];
#pragma unroll
    for (int s = 0; s < 4; ++s) qf[s] = *(const bf16x8*)(F.GQT + (size_t)(t0 + 32 * tt + l31) * 256 + hd * 64 + 16 * s + 8 * hi);
    __syncthreads();    f32x16 Z[4] = {};
    for (int st = 0; st <= tt; ++st) {
        f32x16 X = {};
        const int row = 32 * st + l31;
#pragma unroll
        for (int s = 0; s < 4; ++s) { const bf16x8 a = *(const LAS bf16x8*)(L + GC_KT + row * 128 + (((2 * s + hi) ^ (row & 7)) << 4)); X = __builtin_amdgcn_mfma_f32_32x32x16_bf16(a, qf[s], X, 0, 0, 0); }
        if (st == tt) {
#pragma unroll
            for (int r = 0; r < 16; ++r) if (crow(r, hi) > l31) X[r] = 0.f;
        }
        bf16x8 pa[2];
#pragma unroll
        for (int ks = 0; ks < 2; ++ks) { v4u pw; pw.x = pk2(X[8 * ks], X[8 * ks + 1]); pw.y = pk2(X[8 * ks + 2], X[8 * ks + 3]); pw.z = pk2(X[8 * ks + 4], X[8 * ks + 5]); pw.w = pk2(X[8 * ks + 6], X[8 * ks + 7]); pa[ks] = __builtin_bit_cast(bf16x8, pw); }
#pragma unroll
        for (int ks = 0; ks < 2; ++ks) { const int r0 = 32 * st + 16 * ks + 4 * hi + q4;
#pragma unroll
            for (int dt = 0; dt < 4; ++dt) { const int col = 32 * dt + 16 * g1 + 4 * p4;
                const bf16x8 b = tr_frag(L + GC_V + img256(r0, col), L + GC_V + img256(r0 + 8, col));
                Z[dt] = __builtin_amdgcn_mfma_f32_32x32x16_bf16(pa[ks], b, Z[dt], 0, 0, 0); } }
    }
    if (sflag) {
        if (F.tid < 64) { unsigned sp = 0;
            while ((unsigned)__builtin_amdgcn_readfirstlane(__hip_atomic_load(sflag, __ATOMIC_RELAXED, __HIP_MEMORY_SCOPE_AGENT)) < starget) { __builtin_amdgcn_s_sleep(2); if (++sp > (1u << 20)) break; }
            __builtin_amdgcn_fence(__ATOMIC_ACQUIRE, "agent"); asm volatile("s_waitcnt vmcnt(0)" ::: "memory"); }
        __syncthreads();
    }
#pragma unroll
    for (int i = 0; i < 2; ++i) { const int piece = F.tid + 512 * i, row = piece >> 4, ch = piece & 15;
        *(LAS v4u*)(L + GC_S + row * 256 + ((((ch >> 2) ^ (row & 3))) << 6) + ((ch & 3) << 4)) = __builtin_nontemporal_load((const v4u*)(F.SC + ((size_t)(c * 4 + hd) * 64 + row) * 128 + ch * 8)); }
    __syncthreads();
#pragma unroll
    for (int s = 0; s < 4; ++s) { const int r0 = 16 * s + 8 * hi + q4;
#pragma unroll
        for (int dt = 0; dt < 4; ++dt) { const int col = 32 * dt + 16 * g1 + 4 * p4;
            const bf16x8 b = tr_frag(L + GC_S + img256(r0, col), L + GC_S + img256(r0 + 4, col));
            Z[dt] = __builtin_amdgcn_mfma_f32_32x32x16_bf16(qf[s], b, Z[dt], 0, 0, 0); } }
    float gn[4];
#pragma unroll
    for (int dt = 0; dt < 4; ++dt) gn[dt] = F.glg[32 * dt + l31];
    __syncthreads();    LAS float* stg = (LAS float*)(L + w * 16384);
#pragma unroll
    for (int r = 0; r < 16; ++r) {
        float v = (Z[0][r] * Z[0][r] + Z[1][r] * Z[1][r]) + (Z[2][r] * Z[2][r] + Z[3][r] * Z[3][r]);
        v += __shfl_xor(v, 1); v += __shfl_xor(v, 2); v += __shfl_xor(v, 4); v += __shfl_xor(v, 8); v += __shfl_xor(v, 16);
        const float rs = __builtin_amdgcn_rsqf(v * (1.f / 128.f) + EPS);
#pragma unroll
        for (int dt = 0; dt < 4; ++dt) stg[crow(r, hi) * 128 + 32 * dt + l31] = Z[dt][r] * rs * gn[dt];
    }
    LDS_WAIT(); asm volatile("" ::: "memory");
    u32x2 grv[16];
#pragma unroll
    for (int it = 0; it < 16; ++it) grv[it] = __builtin_nontemporal_load((const u32x2*)(F.GR + (size_t)(t0 + 32 * tt + 2 * it + hi) * 512 + hd * 128 + 4 * l31));
#pragma unroll
    for (int it = 0; it < 16; ++it) { const int row = 2 * it + hi; const size_t t = (size_t)(t0 + 32 * tt + row);
        const f32x4 z = *(const LAS f32x4*)(stg + row * 128 + 4 * l31);
        const u32x2 gr = grv[it];
        u32x2 o; o.x = pk2(z[0] * bflo(gr.x), z[1] * bfhi(gr.x)); o.y = pk2(z[2] * bflo(gr.y), z[3] * bfhi(gr.y));
        *(u32x2*)(F.MIX + t * DM + 512 + hd * 128 + 4 * l31) = o; }
    __syncthreads();
}


constexpr int AT_K = 0, AT_V = 32768, AT_O = 65536;
__device__ __forceinline__ void attn_unit(Frame& F, int kvh, int qb) {
    LAS unsigned char* L = F.lds + RING_OFF;
    const int w = F.wave, lane = F.lane, hi = lane >> 5, l31 = lane & 31, g1 = (lane >> 4) & 1, q4 = (lane & 15) >> 2, p4 = lane & 3;
    const int kbase = 128 * (qb - 1);
    bf16x8 qf[4]; f32x16 X[5];
    auto load_task = [&](int j) {
        const int ti = 2 * w + j, g = ti >> 2, qs = ti & 3, h = 4 * kvh + g;
#pragma unroll
        for (int s = 0; s < 4; ++s) qf[s] = *(const bf16x8*)(F.QKV + ((size_t)(128 * qb + 32 * qs) + l31) * 768 + h * 64 + 16 * s + 8 * hi);
#pragma unroll
        for (int di = 0; di < 5; ++di) {
            const f32x4* bt = (const f32x4*)(F.BTL + ((size_t)((h * 5 + di) * 4) * 64 + lane) * 4);
#pragma unroll
            for (int r4 = 0; r4 < 4; ++r4) { const f32x4 c = bt[r4 * 64]; X[di][4 * r4] = c[0]; X[di][4 * r4 + 1] = c[1]; X[di][4 * r4 + 2] = c[2]; X[di][4 * r4 + 3] = c[3]; }
        }
    };
    load_task(0);
    {
        v4u kvr[4][2];
#pragma unroll
        for (int i = 0; i < 4; ++i) { const int piece = F.tid + 512 * i, row = piece >> 3, ch = piece & 7; const int grow = kbase + row < 0 ? 0 : kbase + row;
            const bf16* kp = F.QKV + (size_t)grow * 768 + 512 + kvh * 64 + ch * 8; kvr[i][0] = *(const v4u*)kp; kvr[i][1] = *(const v4u*)(kp + 128); }
#pragma unroll
        for (int i = 0; i < 4; ++i) { const int piece = F.tid + 512 * i, row = piece >> 3, ch = piece & 7;
            *(LAS v4u*)(L + AT_K + row * 128 + ((ch ^ (row & 7)) << 4)) = kvr[i][0];
            *(LAS v4u*)(L + AT_V + img128t(row, ch * 8)) = kvr[i][1]; }
    }
    __syncthreads();
#pragma unroll 1
    for (int j = 0; j < 2; ++j) {
        const int ti = 2 * w + j, g = ti >> 2, qs = ti & 3, h = 4 * kvh + g;
        const size_t trow = (size_t)(128 * qb + 32 * qs);
        if (j == 1) load_task(1);
        const float sink2 = F.sinks[h] * LOG2E;
        const int di0 = (qb == 0) ? (4 - qs) : 0;
#pragma unroll
        for (int di = 0; di < 5; ++di) {
            if (di >= di0) {
                const int row = 32 * (qs + di) + l31;
#pragma unroll
                for (int s = 0; s < 4; ++s) { const bf16x8 a = *(const LAS bf16x8*)(L + AT_K + row * 128 + (((2 * s + hi) ^ (row & 7)) << 4)); X[di] = __builtin_amdgcn_mfma_f32_32x32x16_bf16(a, qf[s], X[di], 0, 0, 0); }
                __builtin_amdgcn_sched_barrier(0);
            } else {
#pragma unroll
                for (int r = 0; r < 16; ++r) X[di][r] = -INFINITY;
            }
        }
        float m = sink2;
#pragma unroll
        for (int di = 0; di < 5; ++di)
#pragma unroll
            for (int r = 0; r < 16; ++r) m = fmaxf(m, X[di][r]);
        m = fmaxf(m, __shfl_xor(m, 32));
        float l = 0.f;
#pragma unroll
        for (int di = 0; di < 5; ++di)
#pragma unroll
            for (int r = 0; r < 16; ++r) { const float p = __builtin_amdgcn_exp2f(X[di][r] - m); X[di][r] = p; l += p; }
        l += __shfl_xor(l, 32);
        l += __builtin_amdgcn_exp2f(sink2 - m);
        const float inv = 1.f / l;
        f32x16 Z[2] = {};
#pragma unroll
        for (int di = 0; di < 5; ++di) {
            if (di >= di0) {
                bf16x8 pa[2];
#pragma unroll
                for (int ks = 0; ks < 2; ++ks) { v4u pw; pw.x = pk2(X[di][8 * ks] * inv, X[di][8 * ks + 1] * inv); pw.y = pk2(X[di][8 * ks + 2] * inv, X[di][8 * ks + 3] * inv);
                    pw.z = pk2(X[di][8 * ks + 4] * inv, X[di][8 * ks + 5] * inv); pw.w = pk2(X[di][8 * ks + 6] * inv, X[di][8 * ks + 7] * inv); pa[ks] = __builtin_bit_cast(bf16x8, pw); }
#pragma unroll
                for (int ks = 0; ks < 2; ++ks) { const int r0 = 32 * (qs + di) + 16 * ks + 4 * hi + q4;
#pragma unroll
                    for (int dt = 0; dt < 2; ++dt) { const int col = 32 * dt + 16 * g1 + 4 * p4;
                        const bf16x8 b = tr_frag(L + AT_V + img128t(r0, col), L + AT_V + img128t(r0 + 8, col));
                        Z[dt] = __builtin_amdgcn_mfma_f32_32x32x16_bf16(pa[ks], b, Z[dt], 0, 0, 0); } }
            }
        }
        LAS bf16* so = (LAS bf16*)(L + AT_O + w * 4096);
#pragma unroll
        for (int dt = 0; dt < 2; ++dt)
#pragma unroll
            for (int r = 0; r < 16; ++r) so[crow(r, hi) * 64 + 32 * dt + l31] = (bf16)f2bf(Z[dt][r]);
        LDS_WAIT(); asm volatile("" ::: "memory");
#pragma unroll
        for (int it = 0; it < 4; ++it) { const int row = 8 * it + (lane >> 3), ch = lane & 7;
            const v4u v = *(const LAS v4u*)(so + row * 64 + ch * 8);
            *(v4u*)(F.MIX + (trow + row) * DM + h * 64 + ch * 8) = v; }
        LDS_WAIT(); asm volatile("" ::: "memory");
    }
    __syncthreads();
}


__device__ __forceinline__ void attn_sample_unit(Frame& F, int b, int kvh) {
    LAS unsigned char* L = F.lds + RING_OFF;
    LAS float* BTL4 = (LAS float*)(L + AT_O);
    const int w = F.wave, lane = F.lane, hi = lane >> 5, l31 = lane & 31, g1 = (lane >> 4) & 1, q4 = (lane & 15) >> 2, p4 = lane & 3;
    const size_t row = (size_t)(TP + b);
#pragma unroll
    for (int i = 0; i < 2; ++i) { const int piece = F.tid + 512 * i, r = piece >> 3, ch = piece & 7;
        v4u kb, vb;
        if (r < 127) { const size_t so = ((size_t)(b * 128 + r + 1) * 2 + kvh) * 64 + ch * 8, oo = ((size_t)(b * 128 + r) * 2 + kvh) * 64 + ch * 8;
            const f32x4 k0 = __builtin_nontemporal_load((const f32x4*)(F.ck + so)), k1 = __builtin_nontemporal_load((const f32x4*)(F.ck + so + 4));
            const f32x4 v0 = __builtin_nontemporal_load((const f32x4*)(F.cv + so)), v1 = __builtin_nontemporal_load((const f32x4*)(F.cv + so + 4));
            __builtin_nontemporal_store(k0, (f32x4*)(F.out + O_KWS + oo)); __builtin_nontemporal_store(k1, (f32x4*)(F.out + O_KWS + oo + 4));
            __builtin_nontemporal_store(v0, (f32x4*)(F.out + O_VWS + oo)); __builtin_nontemporal_store(v1, (f32x4*)(F.out + O_VWS + oo + 4));
            kb.x = pk2(k0[0], k0[1]); kb.y = pk2(k0[2], k0[3]); kb.z = pk2(k1[0], k1[1]); kb.w = pk2(k1[2], k1[3]);
            vb.x = pk2(v0[0], v0[1]); vb.y = pk2(v0[2], v0[3]); vb.z = pk2(v1[0], v1[1]); vb.w = pk2(v1[2], v1[3]);
        } else { const bf16* kp = F.QKV + row * 768 + 512 + kvh * 64 + ch * 8; kb = *(const v4u*)kp; vb = *(const v4u*)(kp + 128); }
        *(LAS v4u*)(L + AT_K + r * 128 + ((ch ^ (r & 7)) << 4)) = kb;
        *(LAS v4u*)(L + AT_V + img128t(r, ch * 8)) = vb; }
    BTL4[F.tid] = F.BT2[(4 * kvh + (F.tid >> 7)) * 128 + (F.tid & 127)];
    __syncthreads();
    if (w == 0) {
        const int hq = l31 & 3, h = 4 * kvh + hq;
        bf16x8 qf[4];
#pragma unroll
        for (int s = 0; s < 4; ++s) qf[s] = *(const bf16x8*)(F.QKV + row * 768 + h * 64 + 16 * s + 8 * hi);
        const float sink2 = F.sinks[h] * LOG2E;
        f32x16 X[4];
#pragma unroll
        for (int kt = 0; kt < 4; ++kt) {
#pragma unroll
            for (int r = 0; r < 16; ++r) X[kt][r] = BTL4[hq * 128 + 127 - (32 * kt + crow(r, hi))];
            const int krow = 32 * kt + l31;
#pragma unroll
            for (int s = 0; s < 4; ++s) { const bf16x8 a = *(const LAS bf16x8*)(L + AT_K + krow * 128 + (((2 * s + hi) ^ (krow & 7)) << 4)); X[kt] = __builtin_amdgcn_mfma_f32_32x32x16_bf16(a, qf[s], X[kt], 0, 0, 0); }
        }
        float m = sink2;
#pragma unroll
        for (int kt = 0; kt < 4; ++kt)
#pragma unroll
            for (int r = 0; r < 16; ++r) m = fmaxf(m, X[kt][r]);
        m = fmaxf(m, __shfl_xor(m, 32));
        float l = 0.f;
#pragma unroll
        for (int kt = 0; kt < 4; ++kt)
#pragma unroll
            for (int r = 0; r < 16; ++r) { const float p = __builtin_amdgcn_exp2f(X[kt][r] - m); X[kt][r] = p; l += p; }
        l += __shfl_xor(l, 32);
        l += __builtin_amdgcn_exp2f(sink2 - m);
        const float inv = __builtin_amdgcn_rcpf(l);
        f32x16 Z[2] = {};
#pragma unroll
        for (int kt = 0; kt < 4; ++kt) {
            bf16x8 pa[2];
#pragma unroll
            for (int ks = 0; ks < 2; ++ks) { v4u pw; pw.x = pk2(X[kt][8 * ks] * inv, X[kt][8 * ks + 1] * inv); pw.y = pk2(X[kt][8 * ks + 2] * inv, X[kt][8 * ks + 3] * inv);
                pw.z = pk2(X[kt][8 * ks + 4] * inv, X[kt][8 * ks + 5] * inv); pw.w = pk2(X[kt][8 * ks + 6] * inv, X[kt][8 * ks + 7] * inv); pa[ks] = __builtin_bit_cast(bf16x8, pw); }
#pragma unroll
            for (int ks = 0; ks < 2; ++ks) { const int r0 = 32 * kt + 16 * ks + 4 * hi + q4;
#pragma unroll
                for (int dt = 0; dt < 2; ++dt) { const int col = 32 * dt + 16 * g1 + 4 * p4;
                    const bf16x8 bb = tr_frag(L + AT_V + img128t(r0, col), L + AT_V + img128t(r0 + 8, col));
                    Z[dt] = __builtin_amdgcn_mfma_f32_32x32x16_bf16(pa[ks], bb, Z[dt], 0, 0, 0); } }
        }
        if (hi == 0) {
#pragma unroll
            for (int r = 0; r < 4; ++r)
#pragma unroll
                for (int dt = 0; dt < 2; ++dt) F.MIX[row * DM + (4 * kvh + r) * 64 + 32 * dt + l31] = (bf16)f2bf(Z[dt][r]);
        }
    }
    __syncthreads();
}

typedef float f32x4v __attribute__((ext_vector_type(4)));
template <int MODE, int KSTEPS, int NCT>
__device__ __forceinline__ void small_gemm_unit(Frame& F, const bf16* A, const bf16* Bt, int K, int u, int ldsoff) {
    constexpr int NC = 16 * NCT, NUC = DM / NC;
    LAS float* red = (LAS float*)(F.lds + RING_OFF + ldsoff);
    LAS float* sq = (LAS float*)(F.lds + LDSCTL_OFF + 8192);
    const int rt = u / NUC, ct = u % NUC, r0 = 16 * rt, c0 = NC * ct, w = F.wave, lane = F.lane, l15 = lane & 15, kq = lane >> 4;
    const bf16* ap = A + (size_t)(r0 + l15) * K + w * (KSTEPS * 32) + 8 * kq;
    const bf16* bp = Bt + (size_t)(c0 + l15) * K + w * (KSTEPS * 32) + 8 * kq;
    float res_[NCT / 2];
#pragma unroll
    for (int hf = 0; hf < NCT / 2; ++hf) { const int o = F.tid + 512 * hf, j = o >> 8, r = (o >> 6) & 3, ln = o & 63, row = (ln >> 4) * 4 + r, col = 16 * j + (ln & 15);
        res_[hf] = (MODE == 0) ? F.xs[(size_t)(r0 + row) * DM + c0 + col] : bf2f(F.HB[(size_t)(TP + r0 + row) * DM + c0 + col]); }
    bf16x8 af[KSTEPS], bfr[NCT][KSTEPS];
#pragma unroll
    for (int s = 0; s < KSTEPS; ++s) { af[s] = *(const bf16x8*)(ap + 32 * s);
#pragma unroll
        for (int j = 0; j < NCT; ++j) bfr[j][s] = *(const bf16x8*)(bp + (size_t)(16 * j) * K + 32 * s); }
    f32x4v acc[NCT] = {};
#pragma unroll
    for (int s = 0; s < KSTEPS; ++s)
#pragma unroll
        for (int j = 0; j < NCT; ++j) acc[j] = __builtin_amdgcn_mfma_f32_16x16x32_bf16(af[s], bfr[j][s], acc[j], 0, 0, 0);
#pragma unroll
    for (int j = 0; j < NCT; ++j)
#pragma unroll
        for (int r = 0; r < 4; ++r) red[((w * NCT + j) * 4 + r) * 64 + lane] = acc[j][r];
    __syncthreads();
#pragma unroll
    for (int hf = 0; hf < NCT / 2; ++hf) {
        const int o = F.tid + 512 * hf, j = o >> 8, r = (o >> 6) & 3, ln = o & 63;
        float s = 0.f;
#pragma unroll
        for (int ww = 0; ww < 8; ++ww) s += red[((ww * NCT + j) * 4 + r) * 64 + ln];
        const int row = (ln >> 4) * 4 + r, col = 16 * j + (ln & 15);
        const size_t gi = (size_t)(TP + r0 + row) * DM + c0 + col;
        if (MODE == 0) { const float h = res_[hf] + s; F.HB[gi] = (bf16)f2bf(h); sq[row * NC + col] = h * h; }
        else F.out[O_Y + gi] = res_[hf] + s;
    }
    if (MODE == 0) {
        static_assert(MODE != 0 || NCT == 4, "MODE 0 writes one SS2 slot per 64-column unit");
        __syncthreads();
        if (F.tid < 16) { float t = 0.f;
#pragma unroll 8
            for (int c = 0; c < NC; ++c) t += sq[F.tid * NC + ((c + F.tid) & (NC - 1))];
            __hip_atomic_fetch_add(F.SS2 + TP + r0 + F.tid, t, __ATOMIC_RELAXED, __HIP_MEMORY_SCOPE_AGENT); }
    }
    __syncthreads();
}

__global__ void __launch_bounds__(NWAVES * 64, 2) hymba_fwd(Args args) {
    extern __shared__ __attribute__((aligned(16))) unsigned char lds[];
    Frame F;
    F.lds = (LAS unsigned char*)lds;
    F.tid = threadIdx.x; F.lane = F.tid & 63; F.wave = __builtin_amdgcn_readfirstlane(F.tid >> 6); F.G = gridDim.x; F.bid = blockIdx.x;
    F.xp = args.in[0]; F.xs = args.in[1]; F.ck = args.in[2]; F.cv = args.in[3]; F.sg = args.in[4]; F.ang = args.in[5]; F.w_in = args.in[6]; F.qng = args.in[7]; F.kng = args.in[8];
    F.sinks = args.in[9]; F.relb = args.in[10]; F.w2 = args.in[11]; F.bg = args.in[12]; F.glg = args.in[13]; F.w_o = args.in[14]; F.fng = args.in[15]; F.w_gate = args.in[16]; F.w_up = args.in[17]; F.w_down = args.in[18];
    F.out = args.out; F.ws = args.ws;
    unsigned char* ws = args.ws;
    F.W1T = (bf16*)(ws + WS_W1T); F.WOT = (bf16*)(ws + WS_WOT); F.WGUT = (bf16*)(ws + WS_WGUT); F.WDT = (bf16*)(ws + WS_WDT);
    F.XB = (bf16*)(ws + WS_XB); F.QKV = (bf16*)(ws + WS_QKV); F.GQ = (bf16*)(ws + WS_GQ); F.GK = (bf16*)(ws + WS_GK); F.GV = (bf16*)(ws + WS_GV); F.GR = (bf16*)(ws + WS_GR);
    F.MIX = (bf16*)(ws + WS_MIX); F.HB = (bf16*)(ws + WS_HB); F.HID = (bf16*)(ws + WS_HID);
    F.GQT = (bf16*)(ws + WS_GQT); F.GKT = (bf16*)(ws + WS_GKT); F.SS2S = (float*)(ws + WS_SS2S); F.BTL = (float*)(ws + WS_BTL); F.U = (float*)(ws + WS_U); F.SC = (bf16*)(ws + WS_SC); F.DCH = (float*)(ws + WS_DCH);
    F.RSTD = (float*)(ws + WS_RSTD); F.BT2 = (float*)(ws + WS_BT2); F.LR = (bf16*)(ws + WS_LR); F.SS2 = (float*)(ws + WS_SS2);
    for (int u = F.tid; u < (LDS_BYTES - LDSCTL_OFF) / 4; u += NWAVES * 64) ((LAS unsigned*)(F.lds + LDSCTL_OFF))[u] = 0u;
    __syncthreads();
    const int lo = args.ph_lo, hi = args.ph_hi;
    XcdBarrier bar; bar.bar = (unsigned*)(ws + WS_CTL) + CW_BAR; bar.x = 0; bar.st = nullptr;
    if (hi - lo > 1) bar = xcd_barrier_post((unsigned*)(ws + WS_CTL) + CW_BAR, (volatile LAS unsigned*)(F.lds + MISC_OFF) + 8);
#define IN(k) (lo <= (k) && (k) < hi)
#define SEAM(k) do { if (IN(k) && IN((k) + 1)) xcd_barrier(bar); } while (0)
    if (IN(0)) { p0_prologue(F); } SEAM(0);
    if (IN(1)) {
        const int nun = (MP / 256) * (N1 / 256), rounds = (nun + F.G - 1) / F.G, first_idle = nun - (rounds - 1) * F.G, nid = F.G - first_idle;
        if (nid >= 32 && F.bid >= first_idle) { p_chores<0>(F, F.bid - first_idle, nid); __syncthreads(); }
        pg8::Gemm g{F.XB, F.W1T, MP, N1, DM}; pg8::StaticOrder S; S.init(MP, N1, F.G, F.bid);
        pg8::EpiProj E{F.RSTD, F.qng, F.kng, F.QKV, F.GQ, F.GK, F.GV, F.GR, F.LR, F.out, F.bg};
        pg8::gemm_phase<pg8::EpiProj, pg8::StaticOrder, true, true>(F.lds + RING_OFF, g, S, E);
        if (nid < 32) { __syncthreads(); p_chores<0>(F, F.bid, F.G); }
    } SEAM(1);
    const bool keep = (F.G == NCH * 4) && lo <= 2 && hi > 4;
    if (IN(2)) {
        for (int u = F.bid; u < 256; u += F.G) attn_unit(F, u & 1, u >> 1);
        for (int u = F.bid; u < 2 * NSMP; u += F.G) attn_sample_unit(F, u >> 1, u & 1);
        gla_sample(F);
        for (int u = F.bid; u < NCH * 4; u += F.G) gla_a_unit(F, u >> 2, u & 3, keep);
    } SEAM(2);
    constexpr int CW_SCAN = 8320;
    unsigned* scflag = (unsigned*)(ws + WS_CTL) + CW_SCAN;
    const bool merged = (F.G == 256) && lo <= 3 && hi > 4;
    if (IN(3)) {
        gla_scan(F);
        if (merged && F.bid < 64) { asm volatile("s_waitcnt vmcnt(0)" ::: "memory"); __syncthreads();
            if (F.tid == 0) { __builtin_amdgcn_fence(__ATOMIC_RELEASE, "agent"); __hip_atomic_fetch_add(scflag + (F.bid >> 4), 1u, __ATOMIC_RELAXED, __HIP_MEMORY_SCOPE_AGENT); } }
        const int first = F.G >= 192 ? 64 : 0, nb = F.G - first;
        if (F.bid >= first) for (int u = F.bid - first; u < 128; u += nb) small_gemm_unit<0, 4, 4>(F, F.MIX + (size_t)TP * DM, F.WOT, DM, u, 65536);
        if (merged) gla_c_unit(F, F.bid >> 2, F.bid & 3, keep, scflag + (F.bid & 3), 16u);
    }
    if (!merged) { SEAM(3);
        if (IN(4)) { for (int u = F.bid; u < NCH * 4; u += F.G) gla_c_unit(F, u >> 2, u & 3, keep, nullptr, 0u); } }
    SEAM(4);
    if (IN(5)) {
        pg8::Gemm g{F.MIX, F.WOT, TP, DM, DM}; pg8::StaticOrder S; S.init(TP, DM, F.G, F.bid);
        pg8::EpiWo E{F.XB, F.HB, F.SS2};
        pg8::gemm_phase<pg8::EpiWo, pg8::StaticOrder, true, true>(F.lds + RING_OFF, g, S, E);
    } SEAM(5);
    if (IN(6)) {
        constexpr int CW_SFLAG = 8192;
        unsigned* sflag = (unsigned*)(ws + WS_CTL) + CW_SFLAG;
        pg8::Gemm g{F.HB, F.WGUT, MP, NGU, DM}; pg8::SampleFirstOrder S; S.init(TP, NGU, F.G, F.bid, sflag);
        pg8::EpiGU E{F.SS2, F.HID};
        pg8::gemm_phase<pg8::EpiGU, pg8::SampleFirstOrder, true, true>(F.lds + RING_OFF, g, S, E);
        const int nun = (MP / 256) * (NGU / 256), rounds = (nun + F.G - 1) / F.G, first_idle = nun - (rounds - 1) * F.G, nid = F.G - first_idle;
        if (nid >= 64 && F.bid >= first_idle) {
            if (F.tid < 64) { unsigned sp = 0;
                while ((unsigned)__builtin_amdgcn_readfirstlane(__hip_atomic_load(sflag, __ATOMIC_RELAXED, __HIP_MEMORY_SCOPE_AGENT)) < (unsigned)((NGU / 256) * NWAVES)) { __builtin_amdgcn_s_sleep(2); if (++sp > (1u << 20)) break; }
                __builtin_amdgcn_fence(__ATOMIC_ACQUIRE, "agent"); asm volatile("s_waitcnt vmcnt(0)" ::: "memory"); }
            __syncthreads();
            for (int u = F.bid - first_idle; u < 256; u += nid) small_gemm_unit<1, 11, 2>(F, F.HID + (size_t)TP * NFF, F.WDT, NFF, u, 0);
        }
    } SEAM(6);
    if (IN(7)) {
        { const int nun = (MP / 256) * (NGU / 256), rounds = (nun + F.G - 1) / F.G, nid = F.G - (nun - (rounds - 1) * F.G);
          if (nid < 64) for (int u = F.bid; u < 256; u += F.G) small_gemm_unit<1, 11, 2>(F, F.HID + (size_t)TP * NFF, F.WDT, NFF, u, 0); }
        pg8::Gemm g{F.HID, F.WDT, TP, DM, NFF}; pg8::StaticOrder S; S.init(TP, DM, F.G, F.bid);
        pg8::EpiDown E{F.HB, F.out + O_Y};
        pg8::gemm_phase<pg8::EpiDown, pg8::StaticOrder, true, true>(F.lds + RING_OFF, g, S, E);
    }
#undef IN
#undef SEAM
}

extern "C" void kernel_launch(void* const* d_in, const int* in_sizes, int n_in, void* d_out, int out_size, void* d_ws, size_t ws_size, hipStream_t stream) {
    static int grid = 0;
    if (grid == 0) {
        if (n_in != 19 || ws_size < WS_END) { fprintf(stderr, "kernel_launch: unexpected n_in %d / ws %zu\n", n_in, ws_size); grid = -1; return; }
        int dev = 0, cus = 0, per_cu = 0;
        if (hipGetDevice(&dev) != hipSuccess || hipDeviceGetAttribute(&cus, hipDeviceAttributeMultiprocessorCount, dev) != hipSuccess) { grid = -1; return; }
        if (hipFuncSetAttribute((const void*)hymba_fwd, hipFuncAttributeMaxDynamicSharedMemorySize, LDS_BYTES) != hipSuccess) { fprintf(stderr, "kernel_launch: hipFuncSetAttribute failed\n"); grid = -1; return; }
        if (hipOccupancyMaxActiveBlocksPerMultiprocessor(&per_cu, (const void*)hymba_fwd, NWAVES * 64, LDS_BYTES) != hipSuccess || per_cu < 1) { fprintf(stderr, "kernel_launch: occupancy query says %d blocks/CU\n", per_cu); per_cu = 1; }
        (void)hipGetLastError();
        grid = cus;
    }
    if (grid < 0) return;
    (void)hipMemsetAsync((char*)d_ws + WS_CTL, 0, CTL_ZERO_BYTES, stream);
    Args a{};
    for (int i = 0; i < 19; ++i) a.in[i] = (const float*)d_in[i];
    a.out = (float*)d_out; a.ws = (unsigned char*)d_ws;
#if MK_N_LAUNCHES == 1
    a.ph_lo = 0; a.ph_hi = N_PHASES;
    hipLaunchKernelGGL(hymba_fwd, dim3(grid), dim3(NWAVES * 64), LDS_BYTES, stream, a);
#else
    for (int p = 0; p < N_PHASES; ++p) { a.ph_lo = p; a.ph_hi = p + 1; hipLaunchKernelGGL(hymba_fwd, dim3(grid), dim3(NWAVES * 64), LDS_BYTES, stream, a); }
#endif
}
```

```cpp
#include <hip/hip_runtime.h>
#include <cstdio>
#include <cstdint>
#include <cmath>
namespace pg8 {
#define PG8_LAS __attribute__((address_space(3)))
typedef unsigned short bf16_t;
typedef short bf16x8 __attribute__((ext_vector_type(8)));
typedef float f32x4 __attribute__((ext_vector_type(4)));
typedef unsigned u32x4 __attribute__((ext_vector_type(4)));
constexpr int BM = 256, BK = 64, HALF = 128, HTB = HALF * BK * 2  , STAGE_BYTES = 8 * HTB, NXCD = 8, WGM = 4;

__host__ __device__ __forceinline__ int lds_byte(int r, int c) { const int st = (r >> 4) * 2 + (c >> 5), rr = r & 15, cc = c & 31, ob = rr * 64 + cc * 2; return st * 1024 + (ob ^ (((ob >> 9) & 1) << 5)); }
__host__ __device__ __forceinline__ void stage_rc(int b, int& R, int& C) { const int st = b / 1024, sb = b % 1024, swz = sb ^ (((sb >> 9) & 1) << 5); R = (st >> 1) * 16 + swz / 64; C = (st & 1) * 32 + (swz % 64) / 2; }
__host__ __device__ __forceinline__ int perm32(int rho) { const int n = rho >> 4, i = rho & 15; return 8 * (i >> 2) + 4 * n + (i & 3); }

struct Unit { int pm, pn; };
struct Gemm { const bf16_t* A; const bf16_t* Bt; int M, N, K; };

struct StaticOrder {
    int nM, nN, nwg, G, c;
    __host__ __device__ void init(int M, int N, int G_, int c_) { nM = M / BM; nN = N / BM; nwg = nM * nN; G = G_; c = c_; }
    __host__ __device__ bool next(int i, Unit& u) const {
        const long L = (long)i * G + c; if (L >= nwg) return false;
        int wgid = (int)L; { const int q = nwg / NXCD, r = nwg % NXCD, xcd = wgid % NXCD, off = wgid / NXCD; wgid = (xcd < r ? xcd * (q + 1) : r * (q + 1) + (xcd - r) * q) + off; }
        const int nig = WGM * nN, gid = wgid / nig, fm = gid * WGM, gsz = (nM - fm) < WGM ? (nM - fm) : WGM;
        u.pm = fm + ((wgid % nig) % gsz); u.pn = (wgid % nig) / gsz; return true;
    }
    __device__ __forceinline__ void a_ready(const Unit&) const {}
    __device__ __forceinline__ void done(const Unit&) const {}
};

__device__ __forceinline__ unsigned cvt_pk_bf16(float lo, float hi) { unsigned r; asm volatile("v_cvt_pk_bf16_f32 %0, %1, %2" : "=v"(r) : "v"(lo), "v"(hi)); return r; }
typedef float f32x2 __attribute__((ext_vector_type(2)));
constexpr int TP = 16384, NSMP = 128, MV = TP + NSMP, MP = 16640, DM = 1024;
constexpr int N1 = 2560, NFF = 2816, NGU = 2 * NFF;
constexpr float LOG2E = 1.4426950408889634f, EPS = 1e-6f;
constexpr size_t O_Y = 0, O_KWP = 16908288, O_VWP = 16924672, O_SP = 16941056, O_KWS = 16973824, O_VWS = 19070976, O_SS = 21168128;

__device__ __forceinline__ float silu_f(float x) { return x * __builtin_amdgcn_rcpf(1.f + __builtin_amdgcn_exp2f(-1.4426950408889634f * x)); }
__device__ __forceinline__ u32x4 pack8(const f32x4 a, const f32x4 b) { u32x4 w; w.x = cvt_pk_bf16(a[0], a[1]); w.y = cvt_pk_bf16(a[2], a[3]); w.z = cvt_pk_bf16(b[0], b[1]); w.w = cvt_pk_bf16(b[2], b[3]); return w; }
__device__ __forceinline__ void st16_wt(void* p, u32x4 v) { asm volatile("global_store_dwordx4 %0, %1, off sc1\n\ts_nop 1" :: "v"(p), "v"(v) : "memory"); }
typedef unsigned u32x2w __attribute__((ext_vector_type(2)));
__device__ __forceinline__ void st8_wt(void* p, u32x2w v) { asm volatile("global_store_dwordx2 %0, %1, off sc1\n\ts_nop 1" :: "v"(p), "v"(v) : "memory"); }
__device__ __forceinline__ void st16f_wt(void* p, f32x4 v) { asm volatile("global_store_dwordx4 %0, %1, off sc1\n\ts_nop 1" :: "v"(p), "v"(v) : "memory"); }
__device__ __forceinline__ float dot4(const f32x4 a) { return (a[0] * a[0] + a[1] * a[1]) + (a[2] * a[2] + a[3] * a[3]); }

struct EpiProj {
    static constexpr bool PERM = true, AFTER_DRAIN = false;
    const float* rstd; const float* qg; const float* kg;
    bf16_t *QKV, *GQ, *GK, *GV, *GR; bf16_t* LR; float* out; const float* bgate;
    struct Pre { float rs[8]; };
    __device__ __forceinline__ void prefetch(Pre& p, const Unit& u, int wr, int fr) const {
#pragma unroll
        for (int i = 0; i < 8; ++i) { p.rs[i] = rstd[u.pm * BM + wr * 64 + fr + (i >> 2) * HALF + (i & 3) * 16]; }
    }
    __device__ __forceinline__ void operator()(const f32x4 (&acc)[2][2][4][2], const Unit& u, int wr, int wc, int fr, int fq, const Pre& pre) const {
        const int pn = u.pn;
        const int rowb = u.pm * BM + wr * 64 + fr;
        if (pn < 3) {
            const int hh = 4 * pn + wc;
            f32x4 gw[2][2];
#pragma unroll
            for (int bj = 0; bj < 2; ++bj)
#pragma unroll
                for (int n = 0; n < 2; ++n) { const int d = 32 * bj + 8 * fq + 4 * n; gw[bj][n] = hh < 8 ? *(const f32x4*)(qg + d) : (hh < 10 ? *(const f32x4*)(kg + d) : (f32x4){1.f, 1.f, 1.f, 1.f}); }
            const float post = hh < 8 ? 0.125f * LOG2E : 1.f;
#pragma unroll
            for (int ai = 0; ai < 2; ++ai)
#pragma unroll
                for (int m = 0; m < 4; ++m) {
                    const int row = rowb + ai * HALF + m * 16;
                    const float rs = pre.rs[ai * 4 + m];
                    f32x4 v[2][2]; float ss = 0.f;
#pragma unroll
                    for (int bj = 0; bj < 2; ++bj)
#pragma unroll
                        for (int n = 0; n < 2; ++n) { v[bj][n] = acc[ai][bj][m][n] * rs; ss += dot4(v[bj][n]); }
                    if (hh < 10) {
                        ss += __shfl_xor(ss, 16); ss += __shfl_xor(ss, 32);
                        const float rh = __builtin_amdgcn_rsqf(ss * (1.f / 64.f) + EPS) * post;
#pragma unroll
                        for (int bj = 0; bj < 2; ++bj)
#pragma unroll
                            for (int n = 0; n < 2; ++n) v[bj][n] = v[bj][n] * rh * gw[bj][n];
                    }
                    bf16_t* dst = QKV + (size_t)row * 768 + hh * 64 + 8 * fq;
#pragma unroll
                    for (int bj = 0; bj < 2; ++bj) *(u32x4*)(dst + 32 * bj) = pack8(v[bj][0], v[bj][1]);
                    if (hh >= 8) {
                        float* o = nullptr;
                        if (row >= TP - 128 && row < TP) o = out + (hh < 10 ? O_KWP : O_VWP) + (size_t)(row - (TP - 128)) * 128 + (hh & 1) * 64;
                        else if (row >= TP && row < MV) o = out + (hh < 10 ? O_KWS : O_VWS) + ((size_t)(row - TP) * 128 + 127) * 128 + (hh & 1) * 64;
                        if (o) {
#pragma unroll
                            for (int bj = 0; bj < 2; ++bj)
#pragma unroll
                                for (int n = 0; n < 2; ++n) *(f32x4*)(o + 32 * bj + 8 * fq + 4 * n) = v[bj][n];
                        }
                    }
                }
        } else if (pn < 9) {
            bf16_t* base; int ld, cofs, mode;
            if (pn == 3) { base = GQ; ld = 256; cofs = 0; mode = 1; } else if (pn == 4) { base = GK; ld = 256; cofs = 0; mode = 0; }
            else if (pn < 7) { base = GV; ld = 512; cofs = (pn - 5) * 256; mode = 0; } else { base = GR; ld = 512; cofs = (pn - 7) * 256; mode = 2; }
#pragma unroll
            for (int ai = 0; ai < 2; ++ai)
#pragma unroll
                for (int m = 0; m < 4; ++m) {
                    const int row = rowb + ai * HALF + m * 16;
                    const float rs = pre.rs[ai * 4 + m];
                    bf16_t* dst = base + (size_t)row * ld + cofs + wc * 32 + 8 * fq;
#pragma unroll
                    for (int bj = 0; bj < 2; ++bj) {
                        f32x4 a = acc[ai][bj][m][0] * rs, b = acc[ai][bj][m][1] * rs;
                        if (mode == 1) { a = a * 0.125f; b = b * 0.125f; }
                        else if (mode == 2) {
                            const float ce = -LOG2E * rs;
                            f32x4 ta = acc[ai][bj][m][0] * ce, tb = acc[ai][bj][m][1] * ce;
#pragma unroll
                            for (int e = 0; e < 4; ++e) { ta[e] = __builtin_amdgcn_exp2f(ta[e]); tb[e] = __builtin_amdgcn_exp2f(tb[e]); }
                            ta = ta + 1.f; tb = tb + 1.f;
#pragma unroll
                            for (int e = 0; e < 4; ++e) { ta[e] = __builtin_amdgcn_rcpf(ta[e]); tb[e] = __builtin_amdgcn_rcpf(tb[e]); }
                            a = a * ta; b = b * tb;
                        }
                        *(u32x4*)(dst + bj * HALF) = pack8(a, b);
                    }
                }
        } else {
            f32x4 bbv[2][2];
#pragma unroll
            for (int bj = 0; bj < 2; ++bj)
#pragma unroll
                for (int n = 0; n < 2; ++n) bbv[bj][n] = *(const f32x4*)(bgate + bj * HALF + wc * 32 + 8 * fq + 4 * n);
#pragma unroll
            for (int ai = 0; ai < 2; ++ai)
#pragma unroll
                for (int m = 0; m < 4; ++m) {
                    const int row = rowb + ai * HALF + m * 16;
                    const float rs = pre.rs[ai * 4 + m];
#pragma unroll
                    for (int bj = 0; bj < 2; ++bj)
                    { f32x4 la2[2];
#pragma unroll
                        for (int n = 0; n < 2; ++n) { const f32x4 bb = bbv[bj][n]; const f32x4 z = acc[ai][bj][m][n] * rs + bb;
                            f32x4 t, mn;
#pragma unroll
                            for (int e = 0; e < 4; ++e) { t[e] = __builtin_amdgcn_exp2f(-fabsf(z[e]) * LOG2E); mn[e] = fminf(z[e], 0.f); }
                            t = t + 1.f;
#pragma unroll
                            for (int e = 0; e < 4; ++e) t[e] = __log2f(t[e]);
                            la2[n] = mn * 0.0625f - t * (0.0625f * 0.6931471805599453f); }
                        *(u32x4*)(LR + (size_t)row * 256 + bj * HALF + wc * 32 + 8 * fq) = pack8(la2[0], la2[1]); }
                }
        }
    }
};

struct EpiWo {
    static constexpr bool PERM = true, AFTER_DRAIN = false;
    const bf16_t* XB; bf16_t* HB; float* SS2;
    struct Pre {};
    __device__ __forceinline__ void prefetch(Pre&, const Unit&, int, int) const {}
    __device__ __forceinline__ void operator()(const f32x4 (&acc)[2][2][4][2], const Unit& u, int wr, int wc, int fr, int fq, const Pre& pre) const {
        const int rowb = u.pm * BM + wr * 64 + fr, col0 = u.pn * BM + wc * 32 + 8 * fq;
#pragma unroll
        for (int ai = 0; ai < 2; ++ai)
#pragma unroll
            for (int m = 0; m < 4; ++m) {
                const int row = rowb + ai * HALF + m * 16;
                if (row < MV) {
                    float ss = 0.f;
#pragma unroll
                    for (int bj = 0; bj < 2; ++bj) {
                        const size_t gi = (size_t)row * DM + col0 + bj * HALF;
                        const u32x4 xb = *(const u32x4*)(XB + gi);
                        const f32x4 x0 = {__uint_as_float(xb.x << 16), __uint_as_float(xb.x & 0xffff0000u), __uint_as_float(xb.y << 16), __uint_as_float(xb.y & 0xffff0000u)};
                        const f32x4 x1 = {__uint_as_float(xb.z << 16), __uint_as_float(xb.z & 0xffff0000u), __uint_as_float(xb.w << 16), __uint_as_float(xb.w & 0xffff0000u)};
                        const f32x4 h0 = x0 + acc[ai][bj][m][0], h1 = x1 + acc[ai][bj][m][1];
                        *(u32x4*)(HB + gi) = pack8(h0, h1);
                        ss += dot4(h0) + dot4(h1);
                    }
                    ss += __shfl_xor(ss, 16); ss += __shfl_xor(ss, 32);
                    if (fq == 0) __hip_atomic_fetch_add(SS2 + row, ss, __ATOMIC_RELAXED, __HIP_MEMORY_SCOPE_AGENT);
                }
            }
    }
};


struct SampleFirstOrder {
    StaticOrder base; int ns, G, c; unsigned* flag;
    __device__ void init(int Mprompt, int N, int G_, int c_, unsigned* flag_) { ns = N / BM; G = G_; c = c_; flag = flag_; base.init(Mprompt, N, G_, 0); }
    __device__ bool next(int i, Unit& u) const {
        const long L = (long)i * G + c;
        if (L < ns) { u.pm = Mprompt_panels(); u.pn = (int)L; return true; }
        StaticOrder b2 = base; b2.c = 0; b2.G = 1;
        return b2.next((int)(L - ns), u);
    }
    __device__ int Mprompt_panels() const { return base.nM; }
    __device__ __forceinline__ void a_ready(const Unit&) const {}
    __device__ __forceinline__ void done(const Unit& u) const {
        if (u.pm == base.nM) { asm volatile("s_waitcnt vmcnt(0)" ::: "memory"); if ((threadIdx.x & 63) == 0) __hip_atomic_fetch_add(flag, 1u, __ATOMIC_RELAXED, __HIP_MEMORY_SCOPE_AGENT); }
    }
};
struct EpiGU {
    static constexpr bool PERM = true, AFTER_DRAIN = false;
    const float* SS2; bf16_t* HID;
    struct Pre { float ssq[8]; };
    __device__ __forceinline__ void prefetch(Pre& p, const Unit& u, int wr, int fr) const {
#pragma unroll
        for (int i = 0; i < 8; ++i) { const int row = u.pm * BM + wr * 64 + fr + (i >> 2) * HALF + (i & 3) * 16; p.ssq[i] = SS2[row]; }
    }
    __device__ __forceinline__ void operator()(const f32x4 (&acc)[2][2][4][2], const Unit& u, int wr, int wc, int fr, int fq, const Pre& pre) const {
        const int rowb = u.pm * BM + wr * 64 + fr;
#pragma unroll
        for (int ai = 0; ai < 2; ++ai)
#pragma unroll
            for (int m = 0; m < 4; ++m) {
                const int row = rowb + ai * HALF + m * 16;
                const float rs = row < MV ? __builtin_amdgcn_rsqf(pre.ssq[ai * 4 + m] * (1.f / 1024.f) + EPS) : 0.f;
                const f32x2 rs2 = {rs * rs, rs * rs}, cg = {-LOG2E * rs, -LOG2E * rs}, one = {1.f, 1.f};
                f32x4 hv[2];
#pragma unroll
                for (int n = 0; n < 2; ++n)
#pragma unroll
                    for (int h2 = 0; h2 < 2; ++h2) {
                        const f32x2 g = {acc[ai][0][m][n][2 * h2], acc[ai][0][m][n][2 * h2 + 1]}, up = {acc[ai][1][m][n][2 * h2], acc[ai][1][m][n][2 * h2 + 1]};
                        const f32x2 pr = (g * up) * rs2, ex = g * cg;
                        f32x2 dn = {__builtin_amdgcn_exp2f(ex[0]), __builtin_amdgcn_exp2f(ex[1])}; dn = dn + one;
                        const f32x2 rc = {__builtin_amdgcn_rcpf(dn[0]), __builtin_amdgcn_rcpf(dn[1])}, hh = pr * rc;
                        hv[n][2 * h2] = hh[0]; hv[n][2 * h2 + 1] = hh[1];
                    }
                if (u.pm * BM >= TP) st16_wt(HID + (size_t)row * NFF + u.pn * HALF + wc * 32 + 8 * fq, pack8(hv[0], hv[1]));
                else *(u32x4*)(HID + (size_t)row * NFF + u.pn * HALF + wc * 32 + 8 * fq) = pack8(hv[0], hv[1]);
            }
    }
};

struct EpiDown {
    static constexpr bool PERM = true, AFTER_DRAIN = false;
    const bf16_t* HB; float* dsty;
    struct Pre {};
    __device__ __forceinline__ void prefetch(Pre&, const Unit&, int, int) const {}
    __device__ __forceinline__ void operator()(const f32x4 (&acc)[2][2][4][2], const Unit& u, int wr, int wc, int fr, int fq, const Pre& pre) const {
        const int rowb = u.pm * BM + wr * 64 + fr, col0 = u.pn * BM + wc * 32 + 8 * fq;
#pragma unroll
        for (int ai = 0; ai < 2; ++ai)
#pragma unroll
            for (int m = 0; m < 4; ++m) {
                const int row = rowb + ai * HALF + m * 16;
                if (row < MV) {
#pragma unroll
                    for (int bj = 0; bj < 2; ++bj) {
                        const size_t gi = (size_t)row * DM + col0 + bj * HALF;
                        const u32x4 hb = *(const u32x4*)(HB + gi);
                        const f32x4 h0 = {__uint_as_float(hb.x << 16), __uint_as_float(hb.x & 0xffff0000u), __uint_as_float(hb.y << 16), __uint_as_float(hb.y & 0xffff0000u)};
                        const f32x4 h1 = {__uint_as_float(hb.z << 16), __uint_as_float(hb.z & 0xffff0000u), __uint_as_float(hb.w << 16), __uint_as_float(hb.w & 0xffff0000u)};
                        __builtin_nontemporal_store(h0 + acc[ai][bj][m][0], (f32x4*)(dsty + gi));
                        __builtin_nontemporal_store(h1 + acc[ai][bj][m][1], (f32x4*)(dsty + gi + 4));
                    }
                }
            }
    }
};

template <class Epi, class Sched, bool ALIGN_EPI = false, bool SP2 = false>
__device__ __forceinline__ void gemm_phase(PG8_LAS unsigned char* lds, const Gemm g, const Sched& S, const Epi& E) {
    const int tid = threadIdx.x, wid = __builtin_amdgcn_readfirstlane(tid >> 6), lane = tid & 63, wr = wid >> 2, wc = wid & 3, fr = lane & 15, fq = lane >> 4;
    const int K = g.K, nt = K / BK;
    unsigned voffA[2], voffB[2];
#pragma unroll
    for (int i = 0; i < 2; ++i) { int R, C; stage_rc(tid * 16 + i * 8192, R, C); const int Rb = Epi::PERM ? ((R & ~31) + perm32(R & 31)) : R;
        voffA[i] = (unsigned)(R * K + C) * 2u; voffB[i] = (unsigned)(Rb * K + C) * 2u; }
    const size_t kstep = (size_t)(BK * 2);
    const size_t hstep = (size_t)HALF * K * 2;
    const size_t tstep = 2 * hstep;
    const unsigned ldsw = (unsigned)wid * 1024u;
    const int aoff = lds_byte(wr * 64 + fr, fq * 8), boff = lds_byte(wc * 32 + fr, fq * 8);
#define PG8_SA(b, h) (((b) * 2 + (h)) * HTB)
#define PG8_SB(b, h) ((4 + (b) * 2 + (h)) * HTB)
#define PG8_STAGE(bufoff, gbase, voff) do { _Pragma("unroll") for (int _i = 0; _i < 2; ++_i) \
        __builtin_amdgcn_global_load_lds((const unsigned*)((const char*)(gbase) + (voff)[_i]), (PG8_LAS unsigned*)(lds + (bufoff) + ldsw + _i * 8192), 16, 0, 0); } while (0)
#define PG8_LDA(dst, b, h) do { _Pragma("unroll") for (int m = 0; m < 4; ++m) _Pragma("unroll") for (int k = 0; k < 2; ++k) dst[m][k] = *(const PG8_LAS bf16x8*)(lds + PG8_SA(b, h) + aoff + m * 2048 + k * 1024); } while (0)
#define PG8_LDB(dst, b, h) do { _Pragma("unroll") for (int n = 0; n < 2; ++n) _Pragma("unroll") for (int k = 0; k < 2; ++k) dst[n][k] = *(const PG8_LAS bf16x8*)(lds + PG8_SB(b, h) + boff + n * 2048 + k * 1024); } while (0)
#define PG8_MMA(ai, bj, At, Bt) do { __builtin_amdgcn_s_setprio(1); _Pragma("unroll") for (int m = 0; m < 4; ++m) _Pragma("unroll") for (int n = 0; n < 2; ++n) _Pragma("unroll") for (int k = 0; k < 2; ++k) \
        acc[ai][bj][m][n] = __builtin_amdgcn_mfma_f32_16x16x32_bf16(Bt[n][k], At[m][k], acc[ai][bj][m][n], 0, 0, 0); __builtin_amdgcn_s_setprio(0); } while (0)
#define PG8_WAIT_V(n) asm volatile("s_waitcnt vmcnt(" #n ")" ::: "memory")
#define PG8_WAIT_L(n) asm volatile("s_waitcnt lgkmcnt(" #n ")" ::: "memory")
#define PG8_BAR __builtin_amdgcn_s_barrier()
#define PG8_SCHED __builtin_amdgcn_sched_barrier(0)
    Unit cur, nxt; int ui = 0;
    if (!S.next(0, cur)) return;
    f32x4 acc[2][2][4][2];
#pragma unroll
    for (int a = 0; a < 2; ++a)
#pragma unroll
        for (int b = 0; b < 2; ++b)
#pragma unroll
            for (int m = 0; m < 4; ++m)
#pragma unroll
                for (int n = 0; n < 2; ++n) acc[a][b][m][n] = (f32x4){0.f, 0.f, 0.f, 0.f};
    bf16x8 At[4][2], B0[2][2], B1[2][2];
    const char* cA = (const char*)g.A + (size_t)cur.pm * tstep; const char* cB = (const char*)g.Bt + (size_t)cur.pn * tstep;
    S.a_ready(cur);
    if constexpr (SP2) {
        PG8_STAGE(PG8_SB(0, 0), cB, voffB); PG8_STAGE(PG8_SB(0, 1), cB + hstep, voffB); PG8_STAGE(PG8_SA(0, 0), cA, voffA); PG8_STAGE(PG8_SA(0, 1), cA + hstep, voffA);
        if (wr == 1) PG8_BAR;
        PG8_WAIT_V(2); PG8_BAR;
        PG8_STAGE(PG8_SB(1, 0), cB + kstep, voffB); PG8_STAGE(PG8_SA(1, 0), cA + kstep, voffA); PG8_STAGE(PG8_SB(1, 1), cB + hstep + kstep, voffB);
        PG8_WAIT_V(6); PG8_BAR;
    } else {
        PG8_STAGE(PG8_SB(0, 0), cB, voffB); PG8_STAGE(PG8_SA(0, 0), cA, voffA); PG8_STAGE(PG8_SB(0, 1), cB + hstep, voffB); PG8_STAGE(PG8_SA(0, 1), cA + hstep, voffA);
        if (wr == 1) PG8_BAR;
        PG8_WAIT_V(4); PG8_BAR;
        PG8_STAGE(PG8_SB(1, 0), cB + kstep, voffB); PG8_STAGE(PG8_SA(1, 0), cA + kstep, voffA); PG8_STAGE(PG8_SB(1, 1), cB + hstep + kstep, voffB);
        PG8_WAIT_V(6); PG8_BAR;
    }
    for (;;) {
        const bool has_next = S.next(ui + 1, nxt);
        typename Epi::Pre pre; E.prefetch(pre, cur, wr, fr);
        const char* nA = has_next ? (const char*)g.A + (size_t)nxt.pm * tstep : cA; const char* nB = has_next ? (const char*)g.Bt + (size_t)nxt.pn * tstep : cB;
        for (int t = 0; t < nt; t += 2) {
            const bool last = (t == nt - 2);
            const char* a1 = cA + (size_t)(t + 1) * kstep;
            const char* a2 = last ? nA : cA + (size_t)(t + 2) * kstep; const char* b2 = last ? nB : cB + (size_t)(t + 2) * kstep;
            const char* a3 = a2 + kstep; const char* b3 = b2 + kstep;
            if (last && has_next) S.a_ready(nxt);
            if constexpr (SP2) {
            PG8_LDB(B0, 0, 0); PG8_LDB(B1, 0, 1); PG8_SCHED; PG8_LDA(At, 0, 0); PG8_STAGE(PG8_SA(1, 1), a1 + hstep, voffA);
            PG8_WAIT_V(8); PG8_WAIT_L(0); PG8_BAR; PG8_MMA(0, 0, At, B0); PG8_MMA(0, 1, At, B1); PG8_BAR; PG8_SCHED;
            PG8_LDA(At, 0, 1); PG8_STAGE(PG8_SB(0, 0), b2, voffB); PG8_STAGE(PG8_SB(0, 1), b2 + hstep, voffB); PG8_STAGE(PG8_SA(0, 0), a2, voffA);
            PG8_WAIT_V(8); PG8_WAIT_L(0); PG8_BAR; PG8_MMA(1, 0, At, B0); PG8_MMA(1, 1, At, B1); PG8_BAR; PG8_SCHED;
            PG8_LDB(B0, 1, 0); PG8_LDB(B1, 1, 1); PG8_SCHED; PG8_LDA(At, 1, 0); PG8_STAGE(PG8_SA(0, 1), a2 + hstep, voffA);
            PG8_WAIT_V(8); PG8_WAIT_L(0); PG8_BAR; PG8_MMA(0, 0, At, B0); PG8_MMA(0, 1, At, B1); PG8_BAR; PG8_SCHED;
            PG8_LDA(At, 1, 1); PG8_STAGE(PG8_SB(1, 0), b3, voffB); PG8_STAGE(PG8_SB(1, 1), b3 + hstep, voffB); PG8_STAGE(PG8_SA(1, 0), a3, voffA);
            PG8_WAIT_V(8); PG8_WAIT_L(0); PG8_BAR; PG8_MMA(1, 0, At, B0); PG8_MMA(1, 1, At, B1); PG8_BAR; PG8_SCHED;
            } else {
            PG8_LDB(B0, 0, 0); PG8_SCHED; PG8_LDA(At, 0, 0); PG8_STAGE(PG8_SA(1, 1), a1 + hstep, voffA);
            PG8_WAIT_L(8); PG8_BAR; PG8_WAIT_L(0); PG8_MMA(0, 0, At, B0); PG8_BAR; PG8_SCHED;
            PG8_LDB(B1, 0, 1); PG8_STAGE(PG8_SB(0, 0), b2, voffB);
            PG8_BAR; PG8_WAIT_L(0); PG8_MMA(0, 1, At, B1); PG8_BAR;
            PG8_LDA(At, 0, 1); PG8_STAGE(PG8_SA(0, 0), a2, voffA);
            PG8_BAR; PG8_WAIT_L(0); PG8_MMA(1, 0, At, B0); PG8_BAR; PG8_SCHED;
            PG8_STAGE(PG8_SB(0, 1), b2 + hstep, voffB);
            PG8_WAIT_V(6); PG8_BAR; PG8_MMA(1, 1, At, B1); PG8_BAR;
            PG8_LDB(B0, 1, 0); PG8_SCHED; PG8_LDA(At, 1, 0); PG8_STAGE(PG8_SA(0, 1), a2 + hstep, voffA);
            PG8_WAIT_L(8); PG8_BAR; PG8_WAIT_L(0); PG8_MMA(0, 0, At, B0); PG8_BAR; PG8_SCHED;
            PG8_LDB(B1, 1, 1); PG8_STAGE(PG8_SB(1, 0), b3, voffB);
            PG8_BAR; PG8_WAIT_L(0); PG8_MMA(0, 1, At, B1); PG8_BAR;
            PG8_LDA(At, 1, 1); PG8_STAGE(PG8_SA(1, 0), a3, voffA);
            PG8_BAR; PG8_WAIT_L(0); PG8_MMA(1, 0, At, B0); PG8_BAR; PG8_SCHED;
            PG8_STAGE(PG8_SB(1, 1), b3 + hstep, voffB);
            PG8_WAIT_V(6); PG8_BAR; PG8_MMA(1, 1, At, B1); PG8_BAR;
            }
        }
        if constexpr (ALIGN_EPI) { if (wr == 0) PG8_BAR; }
        if constexpr (!Epi::AFTER_DRAIN) { E(acc, cur, wr, wc, fr, fq, pre); S.done(cur); }
        if (!has_next) break;
#pragma unroll
        for (int a = 0; a < 2; ++a)
#pragma unroll
            for (int b = 0; b < 2; ++b)
#pragma unroll
                for (int m = 0; m < 4; ++m)
#pragma unroll
                    for (int n = 0; n < 2; ++n) acc[a][b][m][n] = (f32x4){0.f, 0.f, 0.f, 0.f};
        cur = nxt; cA = nA; cB = nB; ++ui;
        if constexpr (ALIGN_EPI) { if (wr == 1) PG8_BAR; }
    }
    PG8_WAIT_V(0);
    if constexpr (!ALIGN_EPI) { if (wr == 0) PG8_BAR; }
    PG8_BAR;
    if constexpr (Epi::AFTER_DRAIN) { E.fused(acc, cur, wr, wc, fr, fq, lds, wid, lane); S.done(cur); }
#undef PG8_SA
#undef PG8_SB
#undef PG8_STAGE
#undef PG8_LDA
#undef PG8_LDB
#undef PG8_MMA
#undef PG8_WAIT_V
#undef PG8_WAIT_L
#undef PG8_BAR
#undef PG8_SCHED
}
}
#ifndef MK_N_LAUNCHES
#define MK_N_LAUNCHES 1
#endif
constexpr int NWAVES = 8;
constexpr int N_PHASES = 8;
using pg8::TP; using pg8::NSMP; using pg8::MV; using pg8::MP; using pg8::DM; using pg8::N1; using pg8::NFF; using pg8::NGU; using pg8::LOG2E; using pg8::EPS;
using pg8::O_Y; using pg8::O_KWP; using pg8::O_VWP; using pg8::O_SP; using pg8::O_KWS; using pg8::O_VWS; using pg8::O_SS;

constexpr size_t MiB = 1u << 20;
constexpr size_t WS_CTL = 0, CTL_ZERO_BYTES = 64 * 1024;
constexpr size_t WS_W1T = 1 * MiB, WS_WOT = 6 * MiB, WS_WGUT = 8 * MiB, WS_WDT = 19 * MiB;
constexpr size_t WS_RSTD = 25 * MiB, WS_BT2 = 25 * MiB + 128 * 1024, WS_LR = 238 * MiB, WS_SS2 = 27 * MiB + 512 * 1024;
constexpr size_t WS_XB = 29 * MiB;
constexpr size_t WS_QKV = 62 * MiB;
constexpr size_t WS_GQ = 87 * MiB, WS_GK = 96 * MiB, WS_GV = 105 * MiB, WS_GR = 122 * MiB;
constexpr size_t WS_MIX = 139 * MiB;
constexpr size_t WS_HB = 172 * MiB;
constexpr size_t WS_HID = 29 * MiB;
constexpr size_t WS_GQT = 220 * MiB, WS_GKT = 229 * MiB;
constexpr size_t WS_SS2S = 219 * MiB;
constexpr size_t WS_BTL = 218 * MiB;
constexpr size_t WS_U = 205 * MiB, WS_SC = 213 * MiB, WS_DCH = 217 * MiB;
constexpr size_t WS_END = 256 * MiB;
static_assert(WS_HID + (size_t)MP * NFF * 2 <= WS_GR && WS_GR + (size_t)MP * 512 * 2 <= WS_MIX && WS_MIX + (size_t)MP * DM * 2 <= WS_HB && WS_HB + (size_t)MP * DM * 2 <= WS_END, "ws map");
static_assert(WS_XB + (size_t)MP * DM * 2 <= WS_QKV && WS_QKV + (size_t)MP * 768 * 2 <= WS_GQ && WS_GQ + (size_t)MP * 512 <= WS_GK && WS_GK + (size_t)MP * 512 <= WS_GV && WS_GV + (size_t)MP * 1024 <= WS_GR, "ws map 2");
static_assert(WS_W1T + (size_t)N1 * DM * 2 <= WS_WOT && WS_WGUT + (size_t)NGU * DM * 2 <= WS_WDT && WS_WDT + (size_t)DM * NFF * 2 <= WS_RSTD && WS_LR + (size_t)MP * 1024 <= WS_END && WS_SS2 + (size_t)MP * 64 <= WS_XB, "ws map 3");
constexpr int CW_BAR = 1024;

constexpr int RING_OFF = 0, RING_BYTES = 131072;
constexpr int LDSCTL_OFF = RING_BYTES, MISC_OFF = LDSCTL_OFF + 320;
constexpr int LDS_BYTES = 163840;
constexpr int XTRA_OFF = 147456;

#define GAS __attribute__((address_space(1)))
#define LAS __attribute__((address_space(3)))
typedef unsigned short bf16;
typedef unsigned v4u __attribute__((ext_vector_type(4)));
typedef unsigned u32x2 __attribute__((ext_vector_type(2)));
typedef float f32x4 __attribute__((ext_vector_type(4)));
typedef GAS unsigned gu32;
#define RLX_AGENT __ATOMIC_RELAXED, __HIP_MEMORY_SCOPE_AGENT
#define LDS_WAIT() asm volatile("s_waitcnt lgkmcnt(0)" ::: "memory")
typedef float f32x2_t __attribute__((ext_vector_type(2))); typedef __bf16 bf16x2_t __attribute__((ext_vector_type(2)));
__device__ __forceinline__ unsigned pk2(float lo, float hi) { const f32x2_t v = {lo, hi}; const bf16x2_t b = __builtin_convertvector(v, bf16x2_t); return __builtin_bit_cast(unsigned, b); }
__device__ __forceinline__ unsigned f2bf(float f) { return pk2(f, 0.f) & 0xffffu; }
__device__ __forceinline__ float bf2f(unsigned b) { return __uint_as_float(b << 16); }
__device__ __forceinline__ float bflo(unsigned w) { return __uint_as_float(w << 16); }
__device__ __forceinline__ float bfhi(unsigned w) { return __uint_as_float(w & 0xffff0000u); }

#define XB_TMO      128
#define XB_XCNT(j)  (256  + 64 * (j))
#define XB_XSUB(j)  (1280 + 64 * (j))
#define XB_XGEN(j)  (2304 + 64 * (j))
#define XB_TOP      3328
#define XB_TOPGEN   3392
#define XCD_BAR_WORDS 3456
#define XB_SPIN_CAP (1u << 18)
__device__ __forceinline__ unsigned xb_ld(unsigned* p)              { return __hip_atomic_load(p, __ATOMIC_RELAXED, __HIP_MEMORY_SCOPE_AGENT); }
__device__ __forceinline__ unsigned xb_add(unsigned* p, unsigned v) { return __hip_atomic_fetch_add(p, v, __ATOMIC_RELAXED, __HIP_MEMORY_SCOPE_AGENT); }
__device__ __forceinline__ unsigned xb_xcc_id() { return (unsigned)__builtin_amdgcn_s_getreg((3 << 11) | 20) & 0xFu; }
#define XB_SPIN(cond, bar) do { unsigned _sp = 0; while (cond) { __builtin_amdgcn_s_sleep(1); \
    if ((++_sp & 255u) == 0u) { if (xb_ld(&(bar)[XB_TMO])) break; if (_sp > XB_SPIN_CAP) { atomicAdd(&(bar)[XB_TMO], 1u); break; } } } } while (0)
struct XcdBarrier { unsigned* bar; unsigned x; volatile LAS unsigned* st; };
__device__ __forceinline__ XcdBarrier xcd_barrier_post(unsigned* bar, volatile LAS unsigned* st) {
    XcdBarrier b; b.bar = bar; b.x = xb_xcc_id(); b.st = st;
    if (threadIdx.x == 0) (void)xb_add(&bar[XB_XCNT(b.x)], 1u);
    return b;
}
__device__ __forceinline__ void xcd_barrier_complete(unsigned* bar, unsigned x, unsigned& nloc, unsigned& nx) {
    const unsigned G = gridDim.x * gridDim.y * gridDim.z;
    unsigned sum, cnt, mine, sp = 0u;
    for (;;) {
        sum = 0u; cnt = 0u; mine = 0u;
#pragma unroll
        for (unsigned j = 0; j < 16; ++j) { const unsigned c = xb_ld(&bar[XB_XCNT(j)]); sum += c; cnt += (c > 0u) ? 1u : 0u; mine = (j == x) ? c : mine; }
        if (sum == G) break;
        __builtin_amdgcn_s_sleep(1);
        if ((++sp & 255u) == 0u) { if (xb_ld(&bar[XB_TMO])) break; if (sp > XB_SPIN_CAP) { atomicAdd(&bar[XB_TMO], 1u); break; } }
    }
    nloc = mine > 0u ? mine : 1u; nx = cnt > 0u ? cnt : 1u;
}
__device__ __attribute__((noinline)) void xcd_barrier(XcdBarrier b) {
    asm volatile("s_waitcnt vmcnt(0)" ::: "memory");
    __syncthreads();
    if (threadIdx.x == 0) {
        unsigned* bar = b.bar;
        __builtin_amdgcn_s_waitcnt(0);
        unsigned nloc = b.st[0], nx = b.st[1];
        if (nloc == 0u) { xcd_barrier_complete(bar, b.x, nloc, nx); b.st[0] = nloc; b.st[1] = nx; }
        const unsigned old = xb_add(&bar[XB_XSUB(b.x)], 1u);
        const unsigned gen = old / nloc;
        if (old + 1u == (gen + 1u) * nloc) {
            __builtin_amdgcn_fence(__ATOMIC_RELEASE, "agent");
            asm volatile("s_waitcnt vmcnt(0)" ::: "memory");
            const unsigned og = xb_add(&bar[XB_TOP], 1u);
            const unsigned tg = og / nx;
            if (og + 1u == (tg + 1u) * nx) xb_add(&bar[XB_TOPGEN], 1u);
            else XB_SPIN(xb_ld(&bar[XB_TOPGEN]) == tg, bar);
            __builtin_amdgcn_fence(__ATOMIC_ACQUIRE, "agent");
            xb_add(&bar[XB_XGEN(b.x)], 1u);
            asm volatile("s_waitcnt vmcnt(0)" ::: "memory");
        } else {
            XB_SPIN(xb_ld(&bar[XB_XGEN(b.x)]) == gen, bar);
            __builtin_amdgcn_fence(__ATOMIC_ACQUIRE, "agent");
            asm volatile("s_waitcnt vmcnt(0)" ::: "memory");
        }
    }
    __syncthreads();
}

struct Args { const float* in[19]; float* out; unsigned char* ws; int ph_lo, ph_hi; };
struct Frame {
    LAS unsigned char* lds; int tid, lane, wave, G, bid;
    const float *xp, *xs, *ck, *cv, *sg, *ang, *w_in, *qng, *kng, *sinks, *relb, *w2, *bg, *glg, *w_o, *fng, *w_gate, *w_up, *w_down;
    float* out; unsigned char* ws;
    bf16 *W1T, *WOT, *WGUT, *WDT, *XB, *QKV, *GQ, *GK, *GV, *GR, *MIX, *HB, *HID;
    float *RSTD, *BT2, *BTL, *SS2, *SS2S, *U, *DCH; bf16* LR; bf16 *SC, *GQT, *GKT;
};

__device__ __forceinline__ float wave_sum(float v) {
#pragma unroll
    for (int o = 1; o < 64; o <<= 1) v += __shfl_xor(v, o);
    return v;
}
__device__ __forceinline__ float wave_max(float v) {
#pragma unroll
    for (int o = 1; o < 64; o <<= 1) v = fmaxf(v, __shfl_xor(v, o));
    return v;
}

__device__ __forceinline__ int w1_srccol(int n) {
    const int t = n >> 8, s = n & 255;
    if (t < 3) { const int bj = s >> 7, wc = (s >> 5) & 3, j = s & 31; return (4 * t + wc) * 64 + bj * 32 + j; }
    if (t < 9) return 768 + (t - 3) * 256 + s;
    return -2;
}
__device__ __forceinline__ int wgu_srccol(int n) { const int t = n >> 8, s = n & 255; return (s < 128) ? 128 * t + s : NFF + 128 * t + (s - 128); }
__device__ __forceinline__ void conv_item(const float* src, int ld, int col, bool valid, const float* scale, int K, bf16* dst, int n0, int k0, LAS float* scr, int lane) {
    float v[32];
#pragma unroll
    for (int i = 0; i < 32; ++i) { const int kk = 2 * i + (lane >> 5); v[i] = valid ? __builtin_nontemporal_load(src + (size_t)(k0 + kk) * ld + col) : 0.f; }
    if (scale) {
#pragma unroll
        for (int i = 0; i < 32; ++i) v[i] *= scale[k0 + 2 * i + (lane >> 5)]; }
#pragma unroll
    for (int i = 0; i < 32; ++i) scr[(2 * i + (lane >> 5)) * 33 + (lane & 31)] = v[i];
    LDS_WAIT(); asm volatile("" ::: "memory");
    const int c = lane & 7;
#pragma unroll
    for (int j = 0; j < 4; ++j) { const int n = (lane >> 3) + 8 * j; const LAS float* s = scr + (8 * c) * 33 + n;
        v4u o; o.x = pk2(s[0 * 33], s[1 * 33]); o.y = pk2(s[2 * 33], s[3 * 33]); o.z = pk2(s[4 * 33], s[5 * 33]); o.w = pk2(s[6 * 33], s[7 * 33]);
        *(GAS v4u*)(dst + (size_t)(n0 + n) * K + k0 + 8 * c) = o; }
    LDS_WAIT(); asm volatile("" ::: "memory");
}
__device__ __forceinline__ int t5_bucket(int n) {
    if (n < 16) return n;
    const int l = 16 + (int)(logf((float)n / 16.f) / 2.0794415416798357f * 16.f);
    return l < 31 ? l : 31;
}
template <int PART>
__device__ __forceinline__ void p_chores(Frame& F, int wk, int nwk) {
    LAS float* scr = (LAS float*)(F.lds + RING_OFF + F.wave * 16384);
    const int gw = wk * NWAVES + F.wave, NGW = nwk * NWAVES;
    constexpr int IO = 16 * 32, IGU = 16 * (NGU / 32), ID = (NFF / 64) * 32;
    if (PART == 0) {
        { const int gtc = wk * (NWAVES * 64) + F.tid, NGTC = nwk * NWAVES * 64;
        for (int i = gtc; i < 8 * 5 * 4 * 64 * 4; i += NGTC) { const int e = i & 3, ln = (i >> 2) & 63, r4 = (i >> 8) & 3, hd5 = i >> 10, di = hd5 % 5, h = hd5 / 5;
            const int r = 4 * r4 + e, kl = (r & 3) + 8 * (r >> 2) + 4 * (ln >> 5), dist = 128 - 32 * di + (ln & 31) - kl;
            F.BTL[i] = (dist >= 0 && dist < 128) ? F.relb[t5_bucket(dist) * 8 + h] * LOG2E : -INFINITY; }
        if (wk == 0) for (int i = F.tid; i < 8 * 128; i += NWAVES * 64) { const int h = i >> 7, d = i & 127; F.BT2[i] = F.relb[t5_bucket(d) * 8 + h] * LOG2E; }
        }
        for (int it = gw; it < IO + IGU; it += NGW) {
            int r = it;
            if (r < IO) { const int nb = r % 32, kb = r / 32; conv_item(F.w_o, DM, 32 * nb + (F.lane & 31), true, nullptr, DM, F.WOT, 32 * nb, 64 * kb, scr, F.lane); continue; } r -= IO;
            { const int nb = r % (NGU / 32), kb = r / (NGU / 32); const int sc = wgu_srccol(32 * nb + (F.lane & 31));
              const bool up = sc >= NFF; conv_item(up ? F.w_up : F.w_gate, NFF, up ? sc - NFF : sc, true, F.fng, DM, F.WGUT, 32 * nb, 64 * kb, scr, F.lane); }
        }
    }
    if (PART == 0 || PART == 1) for (int it = gw; it < ID; it += NGW) { const int nb = it % 32, kb = it / 32; conv_item(F.w_down, DM, 32 * nb + (F.lane & 31), true, nullptr, NFF, F.WDT, 32 * nb, 64 * kb, scr, F.lane); }
}
__device__ __forceinline__ void p0_prologue(Frame& F) {
    LAS float* scr = (LAS float*)(F.lds + RING_OFF + F.wave * 16384);
    const int gw = F.bid * NWAVES + F.wave, NGW = F.G * NWAVES;
    constexpr int I1 = 16 * (N1 / 32);
    for (int it = gw; it < I1; it += NGW) { const int nb = it % (N1 / 32), kb = it / (N1 / 32); const int n = 32 * nb + (F.lane & 31); const int col = w1_srccol(n);
        if (col != -2) conv_item(F.w_in, 2320, col, col >= 0, F.ang, DM, F.W1T, 32 * nb, 64 * kb, scr, F.lane); }
    {
        const int gt = F.bid * (NWAVES * 64) + F.tid, NGT = F.G * NWAVES * 64;
        for (int i = gt; i < 256 * 128; i += NGT) { const int c = i >> 7, k0 = (i & 127) * 8;
            float w2c[16];
#pragma unroll
            for (int r = 0; r < 16; ++r) w2c[r] = F.w2[r * 256 + c];
            float o[8];
#pragma unroll
            for (int kk = 0; kk < 8; ++kk) { const f32x4* wr = (const f32x4*)(F.w_in + (size_t)(k0 + kk) * 2320 + 2304); float s = 0.f;
#pragma unroll
                for (int r4 = 0; r4 < 4; ++r4) { const f32x4 l = wr[r4]; s += l[0] * w2c[4 * r4] + l[1] * w2c[4 * r4 + 1] + l[2] * w2c[4 * r4 + 2] + l[3] * w2c[4 * r4 + 3]; }
                o[kk] = s * F.ang[k0 + kk]; }
            v4u ov; ov.x = pk2(o[0], o[1]); ov.y = pk2(o[2], o[3]); ov.z = pk2(o[4], o[5]); ov.w = pk2(o[6], o[7]);
            *(GAS v4u*)(F.W1T + (size_t)(2304 + c) * DM + k0) = ov; }
    }
    for (int m0 = 2 * gw; m0 < MP; m0 += 2 * NGW) {
        f32x4 v[2][4];
#pragma unroll
        for (int rr = 0; rr < 2; ++rr) { const int m = m0 + rr;
            if (m < MV) { const float* xrow = m < TP ? F.xp + (size_t)m * DM : F.xs + (size_t)(m - TP) * DM; const GAS f32x4* xr = (const GAS f32x4*)xrow + F.lane;
#pragma unroll
                for (int j = 0; j < 4; ++j) v[rr][j] = __builtin_nontemporal_load(xr + 64 * j); }
            else {
#pragma unroll
                for (int j = 0; j < 4; ++j) v[rr][j] = (f32x4){0.f, 0.f, 0.f, 0.f}; } }
#pragma unroll
        for (int rr = 0; rr < 2; ++rr) { const int m = m0 + rr; float s = 0.f;
#pragma unroll
            for (int j = 0; j < 4; ++j) s += (v[rr][j].x * v[rr][j].x + v[rr][j].y * v[rr][j].y) + (v[rr][j].z * v[rr][j].z + v[rr][j].w * v[rr][j].w);
            s = wave_sum(s);
            if (F.lane == 0) { F.RSTD[m] = m < MV ? rsqrtf(s * (1.f / DM) + EPS) : 0.f; F.SS2[m] = 0.f; }
            GAS unsigned long long* o8 = (GAS unsigned long long*)(F.XB + (size_t)m * DM) + F.lane;
#pragma unroll
            for (int j = 0; j < 4; ++j) o8[64 * j] = (unsigned long long)pk2(v[rr][j].x, v[rr][j].y) | ((unsigned long long)pk2(v[rr][j].z, v[rr][j].w) << 32); }
    }
}

__device__ __forceinline__ void unpack8(const v4u w, float* q) { q[0] = bflo(w.x); q[1] = bfhi(w.x); q[2] = bflo(w.y); q[3] = bfhi(w.y); q[4] = bflo(w.z); q[5] = bfhi(w.z); q[6] = bflo(w.w); q[7] = bfhi(w.w); }
__device__ __forceinline__ float dot64_bf(const float* q, const bf16* k) {
    float s = 0.f;
#pragma unroll
    for (int c = 0; c < 8; ++c) { const v4u w = *(const v4u*)(k + 8 * c); float kk[8]; unpack8(w, kk);
#pragma unroll
        for (int e = 0; e < 8; ++e) s += q[8 * c + e] * kk[e]; }
    return s;
}
__device__ __forceinline__ float dot64_f(const float* q, const float* k) {
    float s = 0.f;
#pragma unroll
    for (int c = 0; c < 16; ++c) { const f32x4 w = *(const f32x4*)(k + 4 * c);
#pragma unroll
        for (int e = 0; e < 4; ++e) s += q[4 * c + e] * w[e]; }
    return s;
}
__device__ __forceinline__ float log_alpha(float z) { return (fminf(z, 0.f) - __logf(1.f + __expf(-fabsf(z)))) * 0.0625f; }
__device__ __forceinline__ void gla_sample(Frame& F) {
    LAS float* oP = (LAS float*)(F.lds + RING_OFF);
    const int w = F.wave, lane = F.lane, ts = w >> 2, qd = w & 3, dv4 = lane & 31, r2 = lane >> 5;
    for (int it = F.bid; it < NSMP * 2; it += F.G) {
        const int task = 2 * it + ts, b = task >> 2, hd = task & 3, row = TP + b;
        const float* S0 = F.sg + ((size_t)(b * 4 + hd) * 64) * 128 + 4 * dv4;
        float* S1 = F.out + O_SS + ((size_t)(b * 4 + hd) * 64) * 128 + 4 * dv4;
        f32x4 s[8]; float a[8], k[8], q[8];
#pragma unroll
        for (int i = 0; i < 8; ++i) { const int dk = 16 * qd + 2 * i + r2, c = hd * 64 + dk; s[i] = __builtin_nontemporal_load((const f32x4*)(S0 + dk * 128));
            a[i] = bf2f(F.LR[(size_t)row * 256 + c]); k[i] = bf2f(F.GK[(size_t)row * 256 + c]); q[i] = bf2f(F.GQ[(size_t)row * 256 + c]); }
        const u32x2 vv = *(const u32x2*)(F.GV + (size_t)row * 512 + hd * 128 + 4 * dv4);
        const f32x4 v = {bflo(vv.x), bfhi(vv.x), bflo(vv.y), bfhi(vv.y)};
        f32x4 o4 = {0.f, 0.f, 0.f, 0.f};
#pragma unroll
        for (int i = 0; i < 8; ++i) { const int dk = 16 * qd + 2 * i + r2; const f32x4 sn = s[i] * __expf(a[i]) + v * k[i]; __builtin_nontemporal_store(sn, (f32x4*)(S1 + dk * 128)); o4 = o4 + sn * q[i]; }
#pragma unroll
        for (int e = 0; e < 4; ++e) o4[e] += __shfl_xor(o4[e], 32);
        if (r2 == 0) *(LAS f32x4*)(oP + (ts * 4 + qd) * 128 + 4 * dv4) = o4;
        __syncthreads();
        if (qd == 0) {
            const LAS float* p = oP + ts * 512;
            const float o0 = (p[lane] + p[128 + lane]) + (p[256 + lane] + p[384 + lane]), o1 = (p[64 + lane] + p[192 + lane]) + (p[320 + lane] + p[448 + lane]);
            const float rs = rsqrtf(wave_sum(o0 * o0 + o1 * o1) * (1.f / 128.f) + EPS);
            const bf16* gr = F.GR + (size_t)row * 512 + hd * 128; bf16* mx = F.MIX + (size_t)row * DM + 512 + hd * 128;
            mx[lane] = (bf16)f2bf(o0 * rs * F.glg[lane] * bf2f(gr[lane]));
            mx[64 + lane] = (bf16)f2bf(o1 * rs * F.glg[64 + lane] * bf2f(gr[64 + lane]));
        }
        __syncthreads();
    }
}
typedef short bf16x8 __attribute__((ext_vector_type(8)));
typedef short v4i16_t __attribute__((ext_vector_type(4)));
typedef float f32x16 __attribute__((ext_vector_type(16)));
constexpr int NCH = TP / 256;
constexpr int GL_V = 0, GL_KH = 65536, GL_LR = 98304, GL_TOT = 114688;
constexpr int GC_V = 0, GC_S = 65536, GC_KT = 98304, GC_QT = 65536;
__device__ __forceinline__ int crow(int r, int hi) { return (r & 3) + 8 * (r >> 2) + 4 * hi; }
__device__ __forceinline__ bf16x8 tr_frag(const LAS unsigned char* p0, const LAS unsigned char* p1) {
    const v4i16_t lo = __builtin_amdgcn_ds_read_tr16_b64_v4i16((LAS v4i16_t*)p0), hi = __builtin_amdgcn_ds_read_tr16_b64_v4i16((LAS v4i16_t*)p1);
    return (bf16x8){lo[0], lo[1], lo[2], lo[3], hi[0], hi[1], hi[2], hi[3]};
}
__device__ __forceinline__ int img256(int row, int col) { return row * 256 + ((((col >> 5) ^ (row & 3))) << 6) + ((col & 31) << 1); }
__device__ __forceinline__ int img128t(int row, int col) { return (row >> 1) * 256 + (((((row & 1) << 1) + (col >> 5)) ^ ((row >> 1) & 1)) << 6) + ((col & 31) << 1); }
__device__ __forceinline__ void stage_v_img(Frame& F, int t0, int hd, LAS unsigned char* img) {
#pragma unroll
    for (int i = 0; i < 8; ++i) { const int piece = F.tid + 512 * i, row = piece >> 4, ch = piece & 15;
        const v4u v = *(const v4u*)(F.GV + (size_t)(t0 + row) * 512 + hd * 128 + ch * 8);
        *(LAS v4u*)(img + row * 256 + ((((ch >> 2) ^ (row & 3))) << 6) + ((ch & 3) << 4)) = v; }
}
__device__ __forceinline__ void gla_a_unit(Frame& F, int c, int hd, bool keep) {
    LAS unsigned char* L = F.lds + RING_OFF;
    LAS float* BIMG = (LAS float*)L; LAS float* TOT = (LAS float*)(F.lds + LDSCTL_OFF + 2048); LAS float* EBT = (LAS float*)(F.lds + LDSCTL_OFF + 4096);
    int tid_ = F.tid; asm volatile("" : "+v"(tid_));
    const int w = F.wave, lane = tid_ & 63, t0 = 256 * c, cc = hd * 64 + lane;
    v4u vreg[8];
#pragma unroll
    for (int i = 0; i < 8; ++i) { const int piece = tid_ + 512 * i, row = piece >> 4, ch = piece & 15; vreg[i] = __builtin_nontemporal_load((const v4u*)(F.GV + (size_t)(t0 + row) * 512 + hd * 128 + ch * 8)); }
    float bl[32]; float run = 0.f;
#pragma unroll
    for (int i = 0; i < 32; ++i) bl[i] = bf2f(__builtin_nontemporal_load(F.LR + (size_t)(t0 + 32 * w + i) * 256 + cc));
#pragma unroll
    for (int i = 0; i < 32; ++i) { run += bl[i]; bl[i] = run; }
    TOT[w * 64 + lane] = run;
    __syncthreads();
    float off = 0.f, btot = 0.f;
#pragma unroll
    for (int ww = 0; ww < 8; ++ww) { const float v = TOT[ww * 64 + lane]; btot += v; if (ww < w) off += v; }
#pragma unroll
    for (int i = 0; i < 32; ++i) BIMG[(32 * w + i) * 64 + lane] = bl[i] + off;
    if (w == 0) { const float ebt = __expf(btot); EBT[lane] = ebt; F.DCH[(c * 4 + hd) * 64 + lane] = ebt; }
    __syncthreads();
    v4u qimg[4];
    v4u q8v[4], k8v[4];
#pragma unroll
    for (int j = 0; j < 4; ++j) { const int it = tid_ + 512 * j, t = it >> 3, ch = it & 7; const size_t gi = (size_t)(t0 + t) * 256 + hd * 64 + ch * 8;
        q8v[j] = __builtin_nontemporal_load((const v4u*)(F.GQ + gi)); k8v[j] = __builtin_nontemporal_load((const v4u*)(F.GK + gi)); }
#pragma unroll
    for (int j = 0; j < 4; ++j) { const int it = tid_ + 512 * j, t = it >> 3, ch = it & 7; const size_t gi = (size_t)(t0 + t) * 256 + hd * 64 + ch * 8;
        const v4u q8 = q8v[j], k8 = k8v[j];
        const f32x4 b0 = *(const LAS f32x4*)(BIMG + t * 64 + ch * 8), b1 = *(const LAS f32x4*)(BIMG + t * 64 + ch * 8 + 4);
        const f32x4 e0 = *(const LAS f32x4*)(EBT + ch * 8), e1 = *(const LAS f32x4*)(EBT + ch * 8 + 4);
        float qv[8], kv[8], bb[8], ee[8]; unpack8(q8, qv); unpack8(k8, kv);
#pragma unroll
        for (int e = 0; e < 4; ++e) { bb[e] = b0[e]; bb[4 + e] = b1[e]; ee[e] = e0[e]; ee[4 + e] = e1[e]; }
        float qt[8], kt[8], kh[8];
#pragma unroll
        for (int e = 0; e < 8; ++e) { const float eb = __builtin_amdgcn_exp2f(bb[e] * LOG2E); kt[e] = kv[e] * __builtin_amdgcn_rcpf(eb); qt[e] = qv[e] * eb; kh[e] = kt[e] * ee[e]; }
        v4u o; o.x = pk2(qt[0], qt[1]); o.y = pk2(qt[2], qt[3]); o.z = pk2(qt[4], qt[5]); o.w = pk2(qt[6], qt[7]); qimg[j] = o; if (!keep) *(v4u*)(F.GQT + gi) = o;
        o.x = pk2(kt[0], kt[1]); o.y = pk2(kt[2], kt[3]); o.z = pk2(kt[4], kt[5]); o.w = pk2(kt[6], kt[7]); *(LAS v4u*)(L + GC_KT + t * 128 + ((ch ^ (t & 7)) << 4)) = o; if (!keep) *(v4u*)(F.GKT + gi) = o;
        o.x = pk2(kh[0], kh[1]); o.y = pk2(kh[2], kh[3]); o.z = pk2(kh[4], kh[5]); o.w = pk2(kh[6], kh[7]); *(LAS v4u*)(L + GL_KH + img128t(t, ch * 8)) = o; }
    __syncthreads();
#pragma unroll
    for (int i = 0; i < 8; ++i) { const int piece = tid_ + 512 * i, row = piece >> 4, ch = piece & 15; *(LAS v4u*)(L + GL_V + row * 256 + ((((ch >> 2) ^ (row & 3))) << 6) + ((ch & 3) << 4)) = vreg[i]; }
    __syncthreads();
    const int kt = w & 1, dt = w >> 1, hi = lane >> 5, g1 = (lane >> 4) & 1, q4 = (lane & 15) >> 2, p4 = lane & 3;
    f32x16 acc = {};
#pragma unroll 4
    for (int st = 0; st < 16; ++st) { const int r0 = 16 * st + 8 * hi + q4;
        const bf16x8 a = tr_frag(L + GL_KH + img128t(r0, 32 * kt + 16 * g1 + 4 * p4), L + GL_KH + img128t(r0 + 4, 32 * kt + 16 * g1 + 4 * p4));
        const bf16x8 b = tr_frag(L + GL_V + img256(r0, 32 * dt + 16 * g1 + 4 * p4), L + GL_V + img256(r0 + 4, 32 * dt + 16 * g1 + 4 * p4));
        acc = __builtin_amdgcn_mfma_f32_32x32x16_bf16(a, b, acc, 0, 0, 0); }
    float* up = F.U + ((size_t)(c * 4 + hd) * 64 + 32 * kt) * 128 + 32 * dt + (lane & 31);
#pragma unroll
    for (int r = 0; r < 16; ++r) up[crow(r, hi) * 128] = acc[r];
    __syncthreads();
    if (keep) {
#pragma unroll
        for (int j = 0; j < 4; ++j) { const int it = tid_ + 512 * j, t = it >> 3, ch = it & 7; *(LAS v4u*)(L + GC_QT + t * 128 + ((ch ^ (t & 7)) << 4)) = qimg[j]; }
        __syncthreads();
    }
}
__device__ __forceinline__ void gla_scan(Frame& F) {
    for (int wv = F.bid * NWAVES + F.wave; wv < 512; wv += F.G * NWAVES) {
        const int id = wv * 64 + F.lane;
        const int hdk = id >> 7;
        float u[NCH], d[NCH];
#pragma unroll
        for (int c = 0; c < NCH; ++c) u[c] = __builtin_nontemporal_load(F.U + (size_t)c * 32768 + id);
#pragma unroll
        for (int c = 0; c < NCH; ++c) d[c] = F.DCH[c * 256 + hdk];
        float S = 0.f;
#pragma unroll
        for (int c = 0; c < NCH; ++c) { F.SC[(size_t)c * 32768 + id] = (bf16)f2bf(S); S = d[c] * S + u[c]; }
        F.out[O_SP + id] = S;
    }
}
__device__ __forceinline__ void gla_c_unit(Frame& F, int c, int hd, bool keep, const unsigned* sflag, unsigned starget) {
    LAS unsigned char* L = F.lds + RING_OFF;
    const int w = F.wave, lane = F.lane, t0 = 256 * c, tt = (w < 4) ? w : 11 - w;
    const int hi = lane >> 5, l31 = lane & 31, g1 = (lane >> 4) & 1, q4 = (lane & 15) >> 2, p4 = lane & 3;
    if (!keep) {
#pragma unroll
    for (int i = 0; i < 4; ++i) { const int piece = F.tid + 512 * i, row = piece >> 3, ch = piece & 7;
        *(LAS v4u*)(L + GC_KT + row * 128 + ((ch ^ (row & 7)) << 4)) = *(const v4u*)(F.GKT + (size_t)(t0 + row) * 256 + hd * 64 + ch * 8); }
    stage_v_img(F, t0, hd, L + GC_V);
    }
    bf16x8 qf[4];
#pragma unroll
    for (int s = 0; s < 4; ++s) { const int qrow = 32 * tt + l31;
        qf[s] = keep ? *(const LAS bf16x8*)(L + GC_QT + qrow * 128 + (((2 * s + hi) ^ (qrow & 7)) << 4)) : *(const bf16x8*)(F.GQT + (size_t)(t0 + qrow) * 256 + hd * 64 + 16 * s + 8 * hi); }
    if (keep) { LDS_WAIT(); asm volatile("" ::: "memory"); }
    __syncthreads();    f32x16 Z[4] = {};
    for (int st = 0; st <= tt; ++st) {
        f32x16 X = {};
        const int row = 32 * st + l31;
#pragma unroll
        for (int s = 0; s < 4; ++s) { const bf16x8 a = *(const LAS bf16x8*)(L + GC_KT + row * 128 + (((2 * s + hi) ^ (row & 7)) << 4)); X = __builtin_amdgcn_mfma_f32_32x32x16_bf16(a, qf[s], X, 0, 0, 0); }
        if (st == tt) {
#pragma unroll
            for (int r = 0; r < 16; ++r) if (crow(r, hi) > l31) X[r] = 0.f;
        }
        bf16x8 pa[2];
#pragma unroll
        for (int ks = 0; ks < 2; ++ks) { v4u pw; pw.x = pk2(X[8 * ks], X[8 * ks + 1]); pw.y = pk2(X[8 * ks + 2], X[8 * ks + 3]); pw.z = pk2(X[8 * ks + 4], X[8 * ks + 5]); pw.w = pk2(X[8 * ks + 6], X[8 * ks + 7]); pa[ks] = __builtin_bit_cast(bf16x8, pw); }
#pragma unroll
        for (int ks = 0; ks < 2; ++ks) { const int r0 = 32 * st + 16 * ks + 4 * hi + q4;
#pragma unroll
            for (int dt = 0; dt < 4; ++dt) { const int col = 32 * dt + 16 * g1 + 4 * p4;
                const bf16x8 b = tr_frag(L + GC_V + img256(r0, col), L + GC_V + img256(r0 + 8, col));
                Z[dt] = __builtin_amdgcn_mfma_f32_32x32x16_bf16(pa[ks], b, Z[dt], 0, 0, 0); } }
    }
    if (sflag) {
        if (F.tid < 64) { unsigned sp = 0;
            while ((unsigned)__builtin_amdgcn_readfirstlane(__hip_atomic_load(sflag, __ATOMIC_RELAXED, __HIP_MEMORY_SCOPE_AGENT)) < starget) { __builtin_amdgcn_s_sleep(2); if (++sp > (1u << 20)) break; }
            __builtin_amdgcn_fence(__ATOMIC_ACQUIRE, "agent"); asm volatile("s_waitcnt vmcnt(0)" ::: "memory"); }
        __syncthreads();
    }
#pragma unroll
    for (int i = 0; i < 2; ++i) { const int piece = F.tid + 512 * i, row = piece >> 4, ch = piece & 15;
        *(LAS v4u*)(L + GC_S + row * 256 + ((((ch >> 2) ^ (row & 3))) << 6) + ((ch & 3) << 4)) = __builtin_nontemporal_load((const v4u*)(F.SC + ((size_t)(c * 4 + hd) * 64 + row) * 128 + ch * 8)); }
    __syncthreads();
#pragma unroll
    for (int s = 0; s < 4; ++s) { const int r0 = 16 * s + 8 * hi + q4;
#pragma unroll
        for (int dt = 0; dt < 4; ++dt) { const int col = 32 * dt + 16 * g1 + 4 * p4;
            const bf16x8 b = tr_frag(L + GC_S + img256(r0, col), L + GC_S + img256(r0 + 4, col));
            Z[dt] = __builtin_amdgcn_mfma_f32_32x32x16_bf16(qf[s], b, Z[dt], 0, 0, 0); } }
    float gn[4];
#pragma unroll
    for (int dt = 0; dt < 4; ++dt) gn[dt] = F.glg[32 * dt + l31];
    __syncthreads();    LAS float* stg = (LAS float*)(L + w * 16384);
#pragma unroll
    for (int r = 0; r < 16; ++r) {
        float v = (Z[0][r] * Z[0][r] + Z[1][r] * Z[1][r]) + (Z[2][r] * Z[2][r] + Z[3][r] * Z[3][r]);
        v += __shfl_xor(v, 1); v += __shfl_xor(v, 2); v += __shfl_xor(v, 4); v += __shfl_xor(v, 8); v += __shfl_xor(v, 16);
        const float rs = __builtin_amdgcn_rsqf(v * (1.f / 128.f) + EPS);
#pragma unroll
        for (int dt = 0; dt < 4; ++dt) stg[crow(r, hi) * 128 + 32 * dt + l31] = Z[dt][r] * rs * gn[dt];
    }
    LDS_WAIT(); asm volatile("" ::: "memory");
    u32x2 grv[16];
#pragma unroll
    for (int it = 0; it < 16; ++it) grv[it] = __builtin_nontemporal_load((const u32x2*)(F.GR + (size_t)(t0 + 32 * tt + 2 * it + hi) * 512 + hd * 128 + 4 * l31));
#pragma unroll
    for (int it = 0; it < 16; ++it) { const int row = 2 * it + hi; const size_t t = (size_t)(t0 + 32 * tt + row);
        const f32x4 z = *(const LAS f32x4*)(stg + row * 128 + 4 * l31);
        const u32x2 gr = grv[it];
        u32x2 o; o.x = pk2(z[0] * bflo(gr.x), z[1] * bfhi(gr.x)); o.y = pk2(z[2] * bflo(gr.y), z[3] * bfhi(gr.y));
        *(u32x2*)(F.MIX + t * DM + 512 + hd * 128 + 4 * l31) = o; }
    __syncthreads();
}


constexpr int AT_K = 0, AT_V = 32768, AT_O = 65536;
__device__ __forceinline__ void attn_unit(Frame& F, int kvh, int qb) {
    LAS unsigned char* L = F.lds + RING_OFF;
    const int w = F.wave, lane = F.lane, hi = lane >> 5, l31 = lane & 31, g1 = (lane >> 4) & 1, q4 = (lane & 15) >> 2, p4 = lane & 3;
    const int kbase = 128 * (qb - 1);
    bf16x8 qf[4]; f32x16 X[5];
    auto load_task = [&](int j) {
        const int ti = 2 * w + j, g = ti >> 2, qs = ti & 3, h = 4 * kvh + g;
#pragma unroll
        for (int s = 0; s < 4; ++s) qf[s] = *(const bf16x8*)(F.QKV + ((size_t)(128 * qb + 32 * qs) + l31) * 768 + h * 64 + 16 * s + 8 * hi);
#pragma unroll
        for (int di = 0; di < 5; ++di) {
            const f32x4* bt = (const f32x4*)(F.BTL + ((size_t)((h * 5 + di) * 4) * 64 + lane) * 4);
#pragma unroll
            for (int r4 = 0; r4 < 4; ++r4) { const f32x4 c = bt[r4 * 64]; X[di][4 * r4] = c[0]; X[di][4 * r4 + 1] = c[1]; X[di][4 * r4 + 2] = c[2]; X[di][4 * r4 + 3] = c[3]; }
        }
    };
    load_task(0);
    {
        v4u kvr[4][2];
#pragma unroll
        for (int i = 0; i < 4; ++i) { const int piece = F.tid + 512 * i, row = piece >> 3, ch = piece & 7; const int grow = kbase + row < 0 ? 0 : kbase + row;
            const bf16* kp = F.QKV + (size_t)grow * 768 + 512 + kvh * 64 + ch * 8; kvr[i][0] = *(const v4u*)kp; kvr[i][1] = *(const v4u*)(kp + 128); }
#pragma unroll
        for (int i = 0; i < 4; ++i) { const int piece = F.tid + 512 * i, row = piece >> 3, ch = piece & 7;
            *(LAS v4u*)(L + AT_K + row * 128 + ((ch ^ (row & 7)) << 4)) = kvr[i][0];
            *(LAS v4u*)(L + AT_V + img128t(row, ch * 8)) = kvr[i][1]; }
    }
    __syncthreads();
#pragma unroll 1
    for (int j = 0; j < 2; ++j) {
        const int ti = 2 * w + j, g = ti >> 2, qs = ti & 3, h = 4 * kvh + g;
        const size_t trow = (size_t)(128 * qb + 32 * qs);
        if (j == 1) load_task(1);
        const float sink2 = F.sinks[h] * LOG2E;
        const int di0 = (qb == 0) ? (4 - qs) : 0;
#pragma unroll
        for (int di = 0; di < 5; ++di) {
            if (di >= di0) {
                const int row = 32 * (qs + di) + l31;
#pragma unroll
                for (int s = 0; s < 4; ++s) { const bf16x8 a = *(const LAS bf16x8*)(L + AT_K + row * 128 + (((2 * s + hi) ^ (row & 7)) << 4)); X[di] = __builtin_amdgcn_mfma_f32_32x32x16_bf16(a, qf[s], X[di], 0, 0, 0); }
                __builtin_amdgcn_sched_barrier(0);
            } else {
#pragma unroll
                for (int r = 0; r < 16; ++r) X[di][r] = -INFINITY;
            }
        }
        float m = sink2;
#pragma unroll
        for (int di = 0; di < 5; ++di)
#pragma unroll
            for (int r = 0; r < 16; ++r) m = fmaxf(m, X[di][r]);
        m = fmaxf(m, __shfl_xor(m, 32));
        float l = 0.f;
#pragma unroll
        for (int di = 0; di < 5; ++di)
#pragma unroll
            for (int r = 0; r < 16; ++r) { const float p = __builtin_amdgcn_exp2f(X[di][r] - m); X[di][r] = p; l += p; }
        l += __shfl_xor(l, 32);
        l += __builtin_amdgcn_exp2f(sink2 - m);
        const float inv = 1.f / l;
        f32x16 Z[2] = {};
#pragma unroll
        for (int di = 0; di < 5; ++di) {
            if (di >= di0) {
                bf16x8 pa[2];
#pragma unroll
                for (int ks = 0; ks < 2; ++ks) { v4u pw; pw.x = pk2(X[di][8 * ks] * inv, X[di][8 * ks + 1] * inv); pw.y = pk2(X[di][8 * ks + 2] * inv, X[di][8 * ks + 3] * inv);
                    pw.z = pk2(X[di][8 * ks + 4] * inv, X[di][8 * ks + 5] * inv); pw.w = pk2(X[di][8 * ks + 6] * inv, X[di][8 * ks + 7] * inv); pa[ks] = __builtin_bit_cast(bf16x8, pw); }
#pragma unroll
                for (int ks = 0; ks < 2; ++ks) { const int r0 = 32 * (qs + di) + 16 * ks + 4 * hi + q4;
#pragma unroll
                    for (int dt = 0; dt < 2; ++dt) { const int col = 32 * dt + 16 * g1 + 4 * p4;
                        const bf16x8 b = tr_frag(L + AT_V + img128t(r0, col), L + AT_V + img128t(r0 + 8, col));
                        Z[dt] = __builtin_amdgcn_mfma_f32_32x32x16_bf16(pa[ks], b, Z[dt], 0, 0, 0); } }
            }
        }
        LAS bf16* so = (LAS bf16*)(L + AT_O + w * 4096);
#pragma unroll
        for (int dt = 0; dt < 2; ++dt)
#pragma unroll
            for (int r = 0; r < 16; ++r) so[crow(r, hi) * 64 + 32 * dt + l31] = (bf16)f2bf(Z[dt][r]);
        LDS_WAIT(); asm volatile("" ::: "memory");
#pragma unroll
        for (int it = 0; it < 4; ++it) { const int row = 8 * it + (lane >> 3), ch = lane & 7;
            const v4u v = *(const LAS v4u*)(so + row * 64 + ch * 8);
            *(v4u*)(F.MIX + (trow + row) * DM + h * 64 + ch * 8) = v; }
        LDS_WAIT(); asm volatile("" ::: "memory");
    }
    __syncthreads();
}


__device__ __forceinline__ void attn_sample_unit(Frame& F, int b, int kvh) {
    LAS unsigned char* L = F.lds + RING_OFF;
    LAS float* BTL4 = (LAS float*)(L + AT_O);
    const int w = F.wave, lane = F.lane, hi = lane >> 5, l31 = lane & 31, g1 = (lane >> 4) & 1, q4 = (lane & 15) >> 2, p4 = lane & 3;
    const size_t row = (size_t)(TP + b);
#pragma unroll
    for (int i = 0; i < 2; ++i) { const int piece = F.tid + 512 * i, r = piece >> 3, ch = piece & 7;
        v4u kb, vb;
        if (r < 127) { const size_t so = ((size_t)(b * 128 + r + 1) * 2 + kvh) * 64 + ch * 8, oo = ((size_t)(b * 128 + r) * 2 + kvh) * 64 + ch * 8;
            const f32x4 k0 = __builtin_nontemporal_load((const f32x4*)(F.ck + so)), k1 = __builtin_nontemporal_load((const f32x4*)(F.ck + so + 4));
            const f32x4 v0 = __builtin_nontemporal_load((const f32x4*)(F.cv + so)), v1 = __builtin_nontemporal_load((const f32x4*)(F.cv + so + 4));
            __builtin_nontemporal_store(k0, (f32x4*)(F.out + O_KWS + oo)); __builtin_nontemporal_store(k1, (f32x4*)(F.out + O_KWS + oo + 4));
            __builtin_nontemporal_store(v0, (f32x4*)(F.out + O_VWS + oo)); __builtin_nontemporal_store(v1, (f32x4*)(F.out + O_VWS + oo + 4));
            kb.x = pk2(k0[0], k0[1]); kb.y = pk2(k0[2], k0[3]); kb.z = pk2(k1[0], k1[1]); kb.w = pk2(k1[2], k1[3]);
            vb.x = pk2(v0[0], v0[1]); vb.y = pk2(v0[2], v0[3]); vb.z = pk2(v1[0], v1[1]); vb.w = pk2(v1[2], v1[3]);
        } else { const bf16* kp = F.QKV + row * 768 + 512 + kvh * 64 + ch * 8; kb = *(const v4u*)kp; vb = *(const v4u*)(kp + 128); }
        *(LAS v4u*)(L + AT_K + r * 128 + ((ch ^ (r & 7)) << 4)) = kb;
        *(LAS v4u*)(L + AT_V + img128t(r, ch * 8)) = vb; }
    BTL4[F.tid] = F.BT2[(4 * kvh + (F.tid >> 7)) * 128 + (F.tid & 127)];
    __syncthreads();
    if (w == 0) {
        const int hq = l31 & 3, h = 4 * kvh + hq;
        bf16x8 qf[4];
#pragma unroll
        for (int s = 0; s < 4; ++s) qf[s] = *(const bf16x8*)(F.QKV + row * 768 + h * 64 + 16 * s + 8 * hi);
        const float sink2 = F.sinks[h] * LOG2E;
        f32x16 X[4];
#pragma unroll
        for (int kt = 0; kt < 4; ++kt) {
#pragma unroll
            for (int r = 0; r < 16; ++r) X[kt][r] = BTL4[hq * 128 + 127 - (32 * kt + crow(r, hi))];
            const int krow = 32 * kt + l31;
#pragma unroll
            for (int s = 0; s < 4; ++s) { const bf16x8 a = *(const LAS bf16x8*)(L + AT_K + krow * 128 + (((2 * s + hi) ^ (krow & 7)) << 4)); X[kt] = __builtin_amdgcn_mfma_f32_32x32x16_bf16(a, qf[s], X[kt], 0, 0, 0); }
        }
        float m = sink2;
#pragma unroll
        for (int kt = 0; kt < 4; ++kt)
#pragma unroll
            for (int r = 0; r < 16; ++r) m = fmaxf(m, X[kt][r]);
        m = fmaxf(m, __shfl_xor(m, 32));
        float l = 0.f;
#pragma unroll
        for (int kt = 0; kt < 4; ++kt)
#pragma unroll
            for (int r = 0; r < 16; ++r) { const float p = __builtin_amdgcn_exp2f(X[kt][r] - m); X[kt][r] = p; l += p; }
        l += __shfl_xor(l, 32);
        l += __builtin_amdgcn_exp2f(sink2 - m);
        const float inv = __builtin_amdgcn_rcpf(l);
        f32x16 Z[2] = {};
#pragma unroll
        for (int kt = 0; kt < 4; ++kt) {
            bf16x8 pa[2];
#pragma unroll
            for (int ks = 0; ks < 2; ++ks) { v4u pw; pw.x = pk2(X[kt][8 * ks] * inv, X[kt][8 * ks + 1] * inv); pw.y = pk2(X[kt][8 * ks + 2] * inv, X[kt][8 * ks + 3] * inv);
                pw.z = pk2(X[kt][8 * ks + 4] * inv, X[kt][8 * ks + 5] * inv); pw.w = pk2(X[kt][8 * ks + 6] * inv, X[kt][8 * ks + 7] * inv); pa[ks] = __builtin_bit_cast(bf16x8, pw); }
#pragma unroll
            for (int ks = 0; ks < 2; ++ks) { const int r0 = 32 * kt + 16 * ks + 4 * hi + q4;
#pragma unroll
                for (int dt = 0; dt < 2; ++dt) { const int col = 32 * dt + 16 * g1 + 4 * p4;
                    const bf16x8 bb = tr_frag(L + AT_V + img128t(r0, col), L + AT_V + img128t(r0 + 8, col));
                    Z[dt] = __builtin_amdgcn_mfma_f32_32x32x16_bf16(pa[ks], bb, Z[dt], 0, 0, 0); } }
        }
        if (hi == 0) {
#pragma unroll
            for (int r = 0; r < 4; ++r)
#pragma unroll
                for (int dt = 0; dt < 2; ++dt) F.MIX[row * DM + (4 * kvh + r) * 64 + 32 * dt + l31] = (bf16)f2bf(Z[dt][r]);
        }
    }
    __syncthreads();
}

typedef float f32x4v __attribute__((ext_vector_type(4)));
template <int MODE, int KSTEPS, int NCT>
__device__ __forceinline__ void small_gemm_unit(Frame& F, const bf16* A, const bf16* Bt, int K, int u, int ldsoff) {
    constexpr int NC = 16 * NCT, NUC = DM / NC;
    LAS float* red = (LAS float*)(F.lds + RING_OFF + ldsoff);
    LAS float* sq = (LAS float*)(F.lds + LDSCTL_OFF + 8192);
    const int rt = u / NUC, ct = u % NUC, r0 = 16 * rt, c0 = NC * ct, w = F.wave, lane = F.lane, l15 = lane & 15, kq = lane >> 4;
    const bf16* ap = A + (size_t)(r0 + l15) * K + w * (KSTEPS * 32) + 8 * kq;
    const bf16* bp = Bt + (size_t)(c0 + l15) * K + w * (KSTEPS * 32) + 8 * kq;
    float res_[NCT / 2];
#pragma unroll
    for (int hf = 0; hf < NCT / 2; ++hf) { const int o = F.tid + 512 * hf, j = o >> 8, r = (o >> 6) & 3, ln = o & 63, row = (ln >> 4) * 4 + r, col = 16 * j + (ln & 15);
        res_[hf] = (MODE == 0) ? F.xs[(size_t)(r0 + row) * DM + c0 + col] : bf2f(F.HB[(size_t)(TP + r0 + row) * DM + c0 + col]); }
    bf16x8 af[KSTEPS], bfr[NCT][KSTEPS];
#pragma unroll
    for (int s = 0; s < KSTEPS; ++s) { af[s] = *(const bf16x8*)(ap + 32 * s);
#pragma unroll
        for (int j = 0; j < NCT; ++j) bfr[j][s] = *(const bf16x8*)(bp + (size_t)(16 * j) * K + 32 * s); }
    f32x4v acc[NCT] = {};
#pragma unroll
    for (int s = 0; s < KSTEPS; ++s)
#pragma unroll
        for (int j = 0; j < NCT; ++j) acc[j] = __builtin_amdgcn_mfma_f32_16x16x32_bf16(af[s], bfr[j][s], acc[j], 0, 0, 0);
#pragma unroll
    for (int hf = 0; hf < NCT / 2; ++hf) {
#pragma unroll
        for (int jj = 0; jj < 2; ++jj)
#pragma unroll
            for (int r = 0; r < 4; ++r) red[((w * 2 + jj) * 4 + r) * 64 + lane] = acc[2 * hf + jj][r];
        __syncthreads();
        const int o = F.tid, jj = o >> 8, j = 2 * hf + jj, r = (o >> 6) & 3, ln = o & 63;
        float s = 0.f;
#pragma unroll
        for (int ww = 0; ww < 8; ++ww) s += red[((ww * 2 + jj) * 4 + r) * 64 + ln];
        const int row = (ln >> 4) * 4 + r, col = 16 * j + (ln & 15);
        const size_t gi = (size_t)(TP + r0 + row) * DM + c0 + col;
        if (MODE == 0) { const float h = res_[hf] + s; F.HB[gi] = (bf16)f2bf(h); sq[row * NC + col] = h * h; }
        else F.out[O_Y + gi] = res_[hf] + s;
        if (hf + 1 < NCT / 2) __syncthreads();
    }
    if (MODE == 0) {
        static_assert(MODE != 0 || NCT == 4, "MODE 0 writes one SS2 slot per 64-column unit");
        __syncthreads();
        if (F.tid < 16) { float t = 0.f;
#pragma unroll 8
            for (int c = 0; c < NC; ++c) t += sq[F.tid * NC + ((c + F.tid) & (NC - 1))];
            __hip_atomic_fetch_add(F.SS2 + TP + r0 + F.tid, t, __ATOMIC_RELAXED, __HIP_MEMORY_SCOPE_AGENT); }
    }
    __syncthreads();
}

__device__ __forceinline__ void sample_wo_unit(Frame& F, int u, int ldsoff) {
    LAS float* red = (LAS float*)(F.lds + RING_OFF + ldsoff);
    LAS float* sq = (LAS float*)(F.lds + LDSCTL_OFF + 8192);
    const bf16* A = F.MIX + (size_t)TP * DM; const bf16* Bt = F.WOT; constexpr int K = DM;
    const int rt = u >> 5, ct = u & 31, r0 = 32 * rt, c0 = 32 * ct, w = F.wave, lane = F.lane, l15 = lane & 15, kq = lane >> 4;
    const bf16* ap = A + (size_t)(r0 + l15) * K + w * 128 + 8 * kq;
    const bf16* bp = Bt + (size_t)(c0 + l15) * K + w * 128 + 8 * kq;
    float res_[2];
#pragma unroll
    for (int g = 0; g < 2; ++g) { const int jj = F.tid >> 8, r = (F.tid >> 6) & 3, ln = F.tid & 63, row = 16 * g + (ln >> 4) * 4 + r, col = 16 * jj + (ln & 15);
        res_[g] = F.xs[(size_t)(r0 + row) * DM + c0 + col]; }
    bf16x8 af[2][4], bfr[2][4];
#pragma unroll
    for (int s = 0; s < 4; ++s)
#pragma unroll
        for (int g = 0; g < 2; ++g) { af[g][s] = *(const bf16x8*)(ap + (size_t)(16 * g) * K + 32 * s); bfr[g][s] = *(const bf16x8*)(bp + (size_t)(16 * g) * K + 32 * s); }
    f32x4v acc[2][2] = {};
#pragma unroll
    for (int s = 0; s < 4; ++s)
#pragma unroll
        for (int g = 0; g < 2; ++g)
#pragma unroll
            for (int jj = 0; jj < 2; ++jj) acc[g][jj] = __builtin_amdgcn_mfma_f32_16x16x32_bf16(af[g][s], bfr[jj][s], acc[g][jj], 0, 0, 0);
#pragma unroll
    for (int g = 0; g < 2; ++g) {
#pragma unroll
        for (int jj = 0; jj < 2; ++jj)
#pragma unroll
            for (int r = 0; r < 4; ++r) red[((w * 2 + jj) * 4 + r) * 64 + lane] = acc[g][jj][r];
        __syncthreads();
        const int jj = F.tid >> 8, r = (F.tid >> 6) & 3, ln = F.tid & 63;
        float sm = 0.f;
#pragma unroll
        for (int ww = 0; ww < 8; ++ww) sm += red[((ww * 2 + jj) * 4 + r) * 64 + ln];
        const int row = 16 * g + (ln >> 4) * 4 + r, col = 16 * jj + (ln & 15);
        const float h = res_[g] + sm;
        F.HB[(size_t)(TP + r0 + row) * DM + c0 + col] = (bf16)f2bf(h); sq[row * 32 + col] = h * h;
        __syncthreads();
    }
    if (F.tid < 32) { float t = 0.f;
#pragma unroll 8
        for (int c = 0; c < 32; ++c) t += sq[F.tid * 32 + ((c + F.tid) & 31)];
        __hip_atomic_fetch_add(F.SS2 + TP + r0 + F.tid, t, __ATOMIC_RELAXED, __HIP_MEMORY_SCOPE_AGENT); }
    __syncthreads();
}

__device__ __forceinline__ void sample_down_unit(Frame& F, int u) {
    LAS float* red = (LAS float*)(F.lds + RING_OFF);
    const bf16* A = F.HID + (size_t)TP * NFF; const bf16* Bt = F.WDT; constexpr int K = NFF;
    const int rt = u >> 5, ct = u & 31, r0 = 64 * rt, c0 = 32 * ct, w = F.wave, lane = F.lane, l15 = lane & 15, kq = lane >> 4;
    const bf16* ap = A + (size_t)(r0 + l15) * K + w * 352 + 8 * kq;
    const bf16* bp = Bt + (size_t)(c0 + l15) * K + w * 352 + 8 * kq;
    float res_[4];
#pragma unroll
    for (int q = 0; q < 4; ++q) { const int o = F.tid + 512 * q, t = o >> 8, r = (o >> 6) & 3, ln = o & 63, row = 16 * (t >> 1) + (ln >> 4) * 4 + r, col = 16 * (t & 1) + (ln & 15);
        res_[q] = bf2f(F.HB[(size_t)(TP + r0 + row) * DM + c0 + col]); }
    f32x4v acc[4][2] = {};
#pragma unroll
    for (int s = 0; s < 11; ++s) {
        bf16x8 af[4], bfr[2];
#pragma unroll
        for (int g = 0; g < 4; ++g) af[g] = *(const bf16x8*)(ap + (size_t)(16 * g) * K + 32 * s);
#pragma unroll
        for (int jj = 0; jj < 2; ++jj) bfr[jj] = *(const bf16x8*)(bp + (size_t)(16 * jj) * K + 32 * s);
#pragma unroll
        for (int g = 0; g < 4; ++g)
#pragma unroll
            for (int jj = 0; jj < 2; ++jj) acc[g][jj] = __builtin_amdgcn_mfma_f32_16x16x32_bf16(af[g], bfr[jj], acc[g][jj], 0, 0, 0);
    }
#pragma unroll
    for (int g = 0; g < 4; ++g)
#pragma unroll
        for (int jj = 0; jj < 2; ++jj)
#pragma unroll
            for (int r = 0; r < 4; ++r) red[((w * 8 + g * 2 + jj) * 4 + r) * 64 + lane] = acc[g][jj][r];
    __syncthreads();
#pragma unroll
    for (int q = 0; q < 4; ++q) { const int o = F.tid + 512 * q, t = o >> 8, r = (o >> 6) & 3, ln = o & 63, row = 16 * (t >> 1) + (ln >> 4) * 4 + r, col = 16 * (t & 1) + (ln & 15);
        float sm = 0.f;
#pragma unroll
        for (int ww = 0; ww < 8; ++ww) sm += red[((ww * 8 + t) * 4 + r) * 64 + ln];
        F.out[O_Y + (size_t)(TP + r0 + row) * DM + c0 + col] = res_[q] + sm; }
    __syncthreads();
}

__global__ void __launch_bounds__(NWAVES * 64, 2) hymba_fwd(Args args) {
    extern __shared__ __attribute__((aligned(16))) unsigned char lds[];
    Frame F;
    F.lds = (LAS unsigned char*)lds;
    F.tid = threadIdx.x; F.lane = F.tid & 63; F.wave = __builtin_amdgcn_readfirstlane(F.tid >> 6); F.G = gridDim.x; F.bid = blockIdx.x;
    F.xp = args.in[0]; F.xs = args.in[1]; F.ck = args.in[2]; F.cv = args.in[3]; F.sg = args.in[4]; F.ang = args.in[5]; F.w_in = args.in[6]; F.qng = args.in[7]; F.kng = args.in[8];
    F.sinks = args.in[9]; F.relb = args.in[10]; F.w2 = args.in[11]; F.bg = args.in[12]; F.glg = args.in[13]; F.w_o = args.in[14]; F.fng = args.in[15]; F.w_gate = args.in[16]; F.w_up = args.in[17]; F.w_down = args.in[18];
    F.out = args.out; F.ws = args.ws;
    unsigned char* ws = args.ws;
    F.W1T = (bf16*)(ws + WS_W1T); F.WOT = (bf16*)(ws + WS_WOT); F.WGUT = (bf16*)(ws + WS_WGUT); F.WDT = (bf16*)(ws + WS_WDT);
    F.XB = (bf16*)(ws + WS_XB); F.QKV = (bf16*)(ws + WS_QKV); F.GQ = (bf16*)(ws + WS_GQ); F.GK = (bf16*)(ws + WS_GK); F.GV = (bf16*)(ws + WS_GV); F.GR = (bf16*)(ws + WS_GR);
    F.MIX = (bf16*)(ws + WS_MIX); F.HB = (bf16*)(ws + WS_HB); F.HID = (bf16*)(ws + WS_HID);
    F.GQT = (bf16*)(ws + WS_GQT); F.GKT = (bf16*)(ws + WS_GKT); F.SS2S = (float*)(ws + WS_SS2S); F.BTL = (float*)(ws + WS_BTL); F.U = (float*)(ws + WS_U); F.SC = (bf16*)(ws + WS_SC); F.DCH = (float*)(ws + WS_DCH);
    F.RSTD = (float*)(ws + WS_RSTD); F.BT2 = (float*)(ws + WS_BT2); F.LR = (bf16*)(ws + WS_LR); F.SS2 = (float*)(ws + WS_SS2);
    for (int u = F.tid; u < (LDS_BYTES - LDSCTL_OFF) / 4; u += NWAVES * 64) ((LAS unsigned*)(F.lds + LDSCTL_OFF))[u] = 0u;
    __syncthreads();
    const int lo = args.ph_lo, hi = args.ph_hi;
    XcdBarrier bar; bar.bar = (unsigned*)(ws + WS_CTL) + CW_BAR; bar.x = 0; bar.st = nullptr;
    if (hi - lo > 1) bar = xcd_barrier_post((unsigned*)(ws + WS_CTL) + CW_BAR, (volatile LAS unsigned*)(F.lds + MISC_OFF) + 8);
#define IN(k) (lo <= (k) && (k) < hi)
#define SEAM(k) do { if (IN(k) && IN((k) + 1)) xcd_barrier(bar); } while (0)
    if (IN(0)) { p0_prologue(F); } SEAM(0);
    if (IN(1)) {
        const int nun = (MP / 256) * (N1 / 256), rounds = (nun + F.G - 1) / F.G, first_idle = nun - (rounds - 1) * F.G, nid = F.G - first_idle;
        if (nid >= 32 && F.bid >= first_idle) { p_chores<0>(F, F.bid - first_idle, nid); __syncthreads(); }
        pg8::Gemm g{F.XB, F.W1T, MP, N1, DM}; pg8::StaticOrder S; S.init(MP, N1, F.G, F.bid);
        pg8::EpiProj E{F.RSTD, F.qng, F.kng, F.QKV, F.GQ, F.GK, F.GV, F.GR, F.LR, F.out, F.bg};
        pg8::gemm_phase<pg8::EpiProj, pg8::StaticOrder, true, true>(F.lds + RING_OFF, g, S, E);
        if (nid < 32) { __syncthreads(); p_chores<0>(F, F.bid, F.G); }
    } SEAM(1);
    const bool keep = (F.G == NCH * 4) && lo <= 2 && hi > 4;
    if (IN(2)) {
        for (int u = F.bid; u < 256; u += F.G) attn_unit(F, u & 1, u >> 1);
        for (int u = F.bid; u < 2 * NSMP; u += F.G) attn_sample_unit(F, u >> 1, u & 1);
        gla_sample(F);
        for (int u = F.bid; u < NCH * 4; u += F.G) gla_a_unit(F, u >> 2, u & 3, keep);
    } SEAM(2);
    constexpr int CW_SCAN = 8320;
    unsigned* scflag = (unsigned*)(ws + WS_CTL) + CW_SCAN;
    const bool merged = (F.G == 256) && lo <= 3 && hi > 4;
    if (IN(3)) {
        gla_scan(F);
        if (merged && F.bid < 64) { asm volatile("s_waitcnt vmcnt(0)" ::: "memory"); __syncthreads();
            if (F.tid == 0) { __builtin_amdgcn_fence(__ATOMIC_RELEASE, "agent"); __hip_atomic_fetch_add(scflag + (F.bid >> 4), 1u, __ATOMIC_RELAXED, __HIP_MEMORY_SCOPE_AGENT); } }
        const int first = F.G >= 192 ? 64 : 0, nb = F.G - first;
        if (F.bid >= first) for (int u = F.bid - first; u < 128; u += nb) sample_wo_unit(F, u, XTRA_OFF);
        if (merged) gla_c_unit(F, F.bid >> 2, F.bid & 3, keep, scflag + (F.bid & 3), 16u);
    }
    if (!merged) { SEAM(3);
        if (IN(4)) { for (int u = F.bid; u < NCH * 4; u += F.G) gla_c_unit(F, u >> 2, u & 3, keep, nullptr, 0u); } }
    SEAM(4);
    if (IN(5)) {
        pg8::Gemm g{F.MIX, F.WOT, TP, DM, DM}; pg8::StaticOrder S; S.init(TP, DM, F.G, F.bid);
        pg8::EpiWo E{F.XB, F.HB, F.SS2};
        pg8::gemm_phase<pg8::EpiWo, pg8::StaticOrder, true, true>(F.lds + RING_OFF, g, S, E);
    } SEAM(5);
    if (IN(6)) {
        constexpr int CW_SFLAG = 8192;
        unsigned* sflag = (unsigned*)(ws + WS_CTL) + CW_SFLAG;
        pg8::Gemm g{F.HB, F.WGUT, MP, NGU, DM}; pg8::SampleFirstOrder S; S.init(TP, NGU, F.G, F.bid, sflag);
        pg8::EpiGU E{F.SS2, F.HID};
        pg8::gemm_phase<pg8::EpiGU, pg8::SampleFirstOrder, true, true>(F.lds + RING_OFF, g, S, E);
        const int nun = (MP / 256) * (NGU / 256), rounds = (nun + F.G - 1) / F.G, first_idle = nun - (rounds - 1) * F.G, nid = F.G - first_idle;
        if (nid >= 64 && F.bid >= first_idle) {
            if (F.tid < 64) { unsigned sp = 0;
                while ((unsigned)__builtin_amdgcn_readfirstlane(__hip_atomic_load(sflag, __ATOMIC_RELAXED, __HIP_MEMORY_SCOPE_AGENT)) < (unsigned)((NGU / 256) * NWAVES)) { __builtin_amdgcn_s_sleep(2); if (++sp > (1u << 20)) break; }
                __builtin_amdgcn_fence(__ATOMIC_ACQUIRE, "agent"); asm volatile("s_waitcnt vmcnt(0)" ::: "memory"); }
            __syncthreads();
            for (int u = F.bid - first_idle; u < 64; u += nid) sample_down_unit(F, u);
        }
    } SEAM(6);
    if (IN(7)) {
        { const int nun = (MP / 256) * (NGU / 256), rounds = (nun + F.G - 1) / F.G, nid = F.G - (nun - (rounds - 1) * F.G);
          if (nid < 64) for (int u = F.bid; u < 256; u += F.G) small_gemm_unit<1, 11, 2>(F, F.HID + (size_t)TP * NFF, F.WDT, NFF, u, 0); }
        pg8::Gemm g{F.HID, F.WDT, TP, DM, NFF}; pg8::StaticOrder S; S.init(TP, DM, F.G, F.bid);
        pg8::EpiDown E{F.HB, F.out + O_Y};
        pg8::gemm_phase<pg8::EpiDown, pg8::StaticOrder, true, true>(F.lds + RING_OFF, g, S, E);
    }
#undef IN
#undef SEAM
}

extern "C" void kernel_launch(void* const* d_in, const int* in_sizes, int n_in, void* d_out, int out_size, void* d_ws, size_t ws_size, hipStream_t stream) {
    static int grid = 0;
    if (grid == 0) {
        if (n_in != 19 || ws_size < WS_END) { fprintf(stderr, "kernel_launch: unexpected n_in %d / ws %zu\n", n_in, ws_size); grid = -1; return; }
        int dev = 0, cus = 0, per_cu = 0;
        if (hipGetDevice(&dev) != hipSuccess || hipDeviceGetAttribute(&cus, hipDeviceAttributeMultiprocessorCount, dev) != hipSuccess) { grid = -1; return; }
        if (hipFuncSetAttribute((const void*)hymba_fwd, hipFuncAttributeMaxDynamicSharedMemorySize, LDS_BYTES) != hipSuccess) { fprintf(stderr, "kernel_launch: hipFuncSetAttribute failed\n"); grid = -1; return; }
        if (hipOccupancyMaxActiveBlocksPerMultiprocessor(&per_cu, (const void*)hymba_fwd, NWAVES * 64, LDS_BYTES) != hipSuccess || per_cu < 1) { fprintf(stderr, "kernel_launch: occupancy query says %d blocks/CU\n", per_cu); per_cu = 1; }
        (void)hipGetLastError();
        grid = cus;
    }
    if (grid < 0) return;
    (void)hipMemsetAsync((char*)d_ws + WS_CTL, 0, CTL_ZERO_BYTES, stream);
    Args a{};
    for (int i = 0; i < 19; ++i) a.in[i] = (const float*)d_in[i];
    a.out = (float*)d_out; a.ws = (unsigned char*)d_ws;
#if MK_N_LAUNCHES == 1
    a.ph_lo = 0; a.ph_hi = N_PHASES;
    hipLaunchKernelGGL(hymba_fwd, dim3(grid), dim3(NWAVES * 64), LDS_BYTES, stream, a);
#else
    for (int p = 0; p < N_PHASES; ++p) { a.ph_lo = p; a.ph_hi = p + 1; hipLaunchKernelGGL(hymba_fwd, dim3(grid), dim3(NWAVES * 64), LDS_BYTES, stream, a); }
#endif
}
```
